# Optimizing an MI355X kernel written in HIP

```python
import jax, jax.numpy as jnp
from jax import lax
import numpy as np

D_MODEL = 1024
BATCH = 16
SEQ = 4096
DEPTH = 1

CTX_LEN = 256
GRID_W = 64
CONV_WIDTH = 512
HGRN_WIDTH = 512
MIX_WIDTH = CONV_WIDTH + HGRN_WIDTH
HGRN_HEAD_DIM = 128
HGRN_HEADS = HGRN_WIDTH // HGRN_HEAD_DIM
CONV_K = 31
CONV_PAD = (CONV_K - 1) // 2
CHUNK = 64
N_EXPERTS = 16
EXPERT_FF = D_MODEL
CAPACITY_FACTOR = 2
N_MOD = 6
EPS = 1e-6

OFF_CONV_A = 0
OFF_CONV_B = OFF_CONV_A + CONV_WIDTH
OFF_Q = OFF_CONV_B + CONV_WIDTH
OFF_I = OFF_Q + HGRN_WIDTH
OFF_FF = OFF_I + HGRN_WIDTH
OFF_FB = OFF_FF + HGRN_WIDTH
OFF_G = OFF_FB + HGRN_WIDTH
IN_COLS = OFF_G + HGRN_WIDTH

kernel_name = 'hymba_conformer_hgrn2_ecmoe_dit'


def rmsnorm(x, g):
    xf = x.astype(jnp.float32)
    y = xf * lax.rsqrt(jnp.mean(xf * xf, axis=-1, keepdims=True) + EPS)
    return (y * g.astype(jnp.float32)).astype(x.dtype)


def layernorm(x, g, b):
    xf = x.astype(jnp.float32)
    mu = jnp.mean(xf, axis=-1, keepdims=True)
    xc = xf - mu
    y = xc * lax.rsqrt(jnp.mean(xc * xc, axis=-1, keepdims=True) + EPS)
    return (y * g.astype(jnp.float32) + b.astype(jnp.float32)).astype(x.dtype)


def modulation(cvec, w, b):
    m = jnp.einsum('bd,de->be', jax.nn.silu(cvec), w) + b
    return [t[:, None, :] for t in jnp.split(m, N_MOD, axis=-1)]


def modulate(h, shift, scale):
    return h * (1 + scale) + shift


def dwconv_seq(u, taps):
    ch = u.shape[-1]
    return lax.conv_general_dilated(u, taps[:, None, :], window_strides=(1,),
                                    padding=[(CONV_PAD, CONV_PAD)],
                                    dimension_numbers=('NWC', 'WIO', 'NWC'),
                                    feature_group_count=ch)


def dwconv_grid(u, taps):
    b, n, ch = u.shape
    rows = n // GRID_W
    g = u.reshape(b, rows, GRID_W, ch)
    half = ch // 2
    dn = ('NHWC', 'HWIO', 'NHWC')
    horiz = lax.conv_general_dilated(g[..., :half], taps[None, :, None, :half], (1, 1),
                                     [(0, 0), (CONV_PAD, CONV_PAD)], dimension_numbers=dn,
                                     feature_group_count=half)
    vert = lax.conv_general_dilated(g[..., half:], taps[:, None, None, half:], (1, 1),
                                    [(CONV_PAD, CONV_PAD), (0, 0)], dimension_numbers=dn,
                                    feature_group_count=ch - half)
    return jnp.concatenate([horiz, vert], axis=-1).reshape(b, n, ch)


def conv_module(proj, taps, bias, ln_g, ln_b, conv_fn):
    u = proj[..., OFF_CONV_A:OFF_CONV_B] * jax.nn.sigmoid(proj[..., OFF_CONV_B:OFF_Q])
    u = conv_fn(u, taps) + bias
    return jax.nn.silu(layernorm(u, ln_g, ln_b))


def split_heads(t):
    b, n, _ = t.shape
    return t.reshape(b, n, HGRN_HEADS, HGRN_HEAD_DIM).transpose(0, 2, 1, 3)


def merge_heads(t):
    b, h, n, d = t.shape
    return t.transpose(0, 2, 1, 3).reshape(b, n, h * d)


def forget_gate(f_logits, lb):
    f = lb + (1.0 - lb) * jax.nn.sigmoid(f_logits.astype(jnp.float32))
    return split_heads(jnp.log(f)), split_heads(1.0 - f)


def gla_scan(k, v, log_f, s0, q=None):
    def to_chunks(t):
        b, h, n, d = t.shape
        return t.reshape(b, h, n // CHUNK, CHUNK, d).transpose(2, 0, 1, 3, 4)

    causal = jnp.tril(jnp.ones((CHUNK, CHUNK), dtype=bool))

    def step(state, xs):
        if q is None:
            kc, vc, gc = xs
        else:
            qc, kc, vc, gc = xs
        b = jnp.cumsum(gc, axis=2)
        b_last = b[:, :, -1:, :]
        k_dec = kc * jnp.exp(b_last - b)
        new_state = (jnp.exp(b_last[:, :, 0, :, None]) * state
                     + jnp.einsum('bhck,bhcv->bhkv', k_dec, vc))
        if q is None:
            return new_state, None
        o_inter = jnp.einsum('bhtk,bhkv->bhtv', qc * jnp.exp(b), state)
        diff = b[:, :, :, None, :] - b[:, :, None, :, :]
        decay = jnp.exp(jnp.where(causal[:, :, None], diff, -jnp.inf))
        scores = jnp.einsum('bhtk,bhsk,bhtsk->bhts', qc, kc, decay)
        o = o_inter + jnp.einsum('bhts,bhsv->bhtv', scores, vc)
        return new_state, o

    inputs = (k, v, log_f) if q is None else (q, k, v, log_f)
    xs = tuple(to_chunks(t) for t in inputs)
    state, o = lax.scan(step, s0, xs)
    if q is None:
        return state, None
    nc, b, h, cl, dv = o.shape
    return state, o.transpose(1, 2, 0, 3, 4).reshape(b, h, nc * cl, dv)


def hgrn_bidir(p_i, p_ff, p_fb, lb_l, s0_f, s0_b, q=None):
    v = split_heads(p_i.astype(jnp.float32))
    logf_f, k_f = forget_gate(p_ff, lb_l[0])
    logf_b, k_b = forget_gate(p_fb, lb_l[1])
    rev = lambda t: t[:, :, ::-1]
    qh = None if q is None else split_heads(q.astype(jnp.float32))
    s_f, o_f = gla_scan(k_f, v, logf_f, s0_f, qh)
    s_b, o_b = gla_scan(rev(k_b), rev(v), rev(logf_b), s0_b, None if qh is None else rev(qh))
    if q is None:
        return None, s_f, s_b
    return o_f + rev(o_b), s_f, s_b


def hgrn_readout(o, g, norm_g):
    y = o * lax.rsqrt(jnp.mean(o * o, axis=-1, keepdims=True) + EPS)
    return merge_heads(y) * norm_g.astype(jnp.float32) * jax.nn.silu(g.astype(jnp.float32))


def token_mixer(h, p, lb_l, conv_fn, s0_f, s0_b):
    proj = jnp.einsum('bnd,dc->bnc', h, p['w_in'])
    conv_out = conv_module(proj, p['taps'], p['conv_bias'], p['ln_g'], p['ln_b'], conv_fn)
    o, s_f, s_b = hgrn_bidir(proj[..., OFF_I:OFF_FF], proj[..., OFF_FF:OFF_FB],
                             proj[..., OFF_FB:OFF_G], lb_l, s0_f, s0_b,
                             q=proj[..., OFF_Q:OFF_I])
    hg = hgrn_readout(o, proj[..., OFF_G:IN_COLS], p['hgrn_g']).astype(h.dtype)
    mixed = jnp.concatenate([conv_out.astype(h.dtype), hg], axis=-1)
    return jnp.einsum('bnc,cd->bnd', mixed, p['w_out']), s_f, s_b


def expert_choice_ffn(h, p):
    b, n, d = h.shape
    cap = CAPACITY_FACTOR * n // N_EXPERTS
    logits = jnp.einsum('bnd,de->bne', h, p['router']).astype(jnp.float32)
    probs = jax.nn.softmax(logits, axis=-1)
    gate, idx = lax.top_k(probs.transpose(0, 2, 1), cap)
    xs = jax.vmap(lambda hb, ib: hb[ib])(h, idx)
    hid = (jax.nn.silu(jnp.einsum('becd,edf->becf', xs, p['w_gate']))
           * jnp.einsum('becd,edf->becf', xs, p['w_up']))
    out = jnp.einsum('becf,efd->becd', hid, p['w_down']) * gate[..., None].astype(h.dtype)
    y = jax.vmap(lambda ob, ib: jnp.zeros((n, d), ob.dtype).at[ib.reshape(-1)].add(
        ob.reshape(-1, d)))(out, idx)
    return y.astype(h.dtype)


def setup_inputs(seed: int = 0) -> dict:
    key = jax.random.key(seed)
    ks = jax.random.split(key, 21)
    f32 = jnp.float32

    def nrm(k, shape, scale):
        return jax.random.normal(k, shape, f32) * scale

    return {
        'x': nrm(ks[0], (BATCH, SEQ, D_MODEL), 1.0),
        'c': nrm(ks[1], (BATCH, D_MODEL), 1.0),
        'ctx': nrm(ks[2], (BATCH, CTX_LEN, D_MODEL), 1.0),
        'c_ctx': nrm(ks[3], (D_MODEL,), 1.0),
        'ada_w': nrm(ks[4], (DEPTH, D_MODEL, N_MOD * D_MODEL), D_MODEL ** -0.5),
        'ada_b': nrm(ks[5], (DEPTH, N_MOD * D_MODEL), 0.02),
        'norm1_g': 1.0 + nrm(ks[6], (DEPTH, D_MODEL), 0.02),
        'w_in': nrm(ks[7], (DEPTH, D_MODEL, IN_COLS), D_MODEL ** -0.5),
        'conv_taps': nrm(ks[8], (DEPTH, CONV_K, CONV_WIDTH), CONV_K ** -0.5),
        'conv_bias': nrm(ks[9], (DEPTH, CONV_WIDTH), 0.02),
        'conv_ln_g': 1.0 + nrm(ks[10], (DEPTH, CONV_WIDTH), 0.02),
        'conv_ln_b': nrm(ks[11], (DEPTH, CONV_WIDTH), 0.02),
        'hgrn_lb_logits': nrm(ks[12], (DEPTH + 1, 2, HGRN_WIDTH), 0.5),
        'hgrn_norm_g': 1.0 + nrm(ks[13], (DEPTH, HGRN_WIDTH), 0.02),
        'w_out': nrm(ks[14], (DEPTH, MIX_WIDTH, D_MODEL), MIX_WIDTH ** -0.5),
        'norm2_g': 1.0 + nrm(ks[15], (DEPTH, D_MODEL), 0.02),
        'router_w': nrm(ks[16], (DEPTH, D_MODEL, N_EXPERTS), D_MODEL ** -0.5),
        'w_gate': nrm(ks[17], (DEPTH, N_EXPERTS, D_MODEL, EXPERT_FF), D_MODEL ** -0.5),
        'w_up': nrm(ks[18], (DEPTH, N_EXPERTS, D_MODEL, EXPERT_FF), D_MODEL ** -0.5),
        'w_down': nrm(ks[19], (DEPTH, N_EXPERTS, EXPERT_FF, D_MODEL), EXPERT_FF ** -0.5),
        'final_g': 1.0 + nrm(ks[20], (D_MODEL,), 0.02),
    }


def reference(x, c, ctx, c_ctx, ada_w, ada_b, norm1_g, w_in, conv_taps, conv_bias,
              conv_ln_g, conv_ln_b, hgrn_lb_logits, hgrn_norm_g, w_out, norm2_g,
              router_w, w_gate, w_up, w_down, final_g):
    lower_bounds = jnp.cumsum(jax.nn.softmax(hgrn_lb_logits.astype(jnp.float32), axis=0),
                              axis=0)[:DEPTH]
    bsz = x.shape[0]
    zero_state = jnp.zeros((bsz, HGRN_HEADS, HGRN_HEAD_DIM, HGRN_HEAD_DIM), jnp.float32)
    for l in range(DEPTH):
        p = {'w_in': w_in[l], 'taps': conv_taps[l], 'conv_bias': conv_bias[l],
             'ln_g': conv_ln_g[l], 'ln_b': conv_ln_b[l], 'hgrn_g': hgrn_norm_g[l],
             'w_out': w_out[l], 'router': router_w[l], 'w_gate': w_gate[l],
             'w_up': w_up[l], 'w_down': w_down[l]}
        sh1, sc1, g1, sh2, sc2, g2 = modulation(c, ada_w[l], ada_b[l])
        csh1, csc1, cg1, csh2, csc2, cg2 = modulation(c_ctx[None, :], ada_w[l], ada_b[l])

        h_ctx = modulate(rmsnorm(ctx, norm1_g[l]), csh1, csc1)
        if l == DEPTH - 1:
            p_ctx = jnp.einsum('bnd,dc->bnc', h_ctx, w_in[l][:, OFF_I:OFF_G])
            _, s_f, s_b = hgrn_bidir(p_ctx[..., :HGRN_WIDTH],
                                     p_ctx[..., HGRN_WIDTH:2 * HGRN_WIDTH],
                                     p_ctx[..., 2 * HGRN_WIDTH:], lower_bounds[l],
                                     zero_state, zero_state)
        else:
            mix_ctx, s_f, s_b = token_mixer(h_ctx, p, lower_bounds[l], dwconv_seq,
                                            zero_state, zero_state)
            ctx = ctx + cg1 * mix_ctx
            ctx = ctx + cg2 * expert_choice_ffn(modulate(rmsnorm(ctx, norm2_g[l]), csh2, csc2), p)

        h = modulate(rmsnorm(x, norm1_g[l]), sh1, sc1)
        mix, _, _ = token_mixer(h, p, lower_bounds[l], dwconv_grid, s_f, s_b)
        x = x + g1 * mix
        x = x + g2 * expert_choice_ffn(modulate(rmsnorm(x, norm2_g[l]), sh2, sc2), p)
    return rmsnorm(x, final_g)
```

```cpp
#include <hip/hip_runtime.h>
#include <cstdio>

#define LAS __attribute__((address_space(3)))
#define DI __device__ __forceinline__
typedef unsigned short bf16_t;
typedef short bf16x8 __attribute__((ext_vector_type(8)));
typedef float f32x4 __attribute__((ext_vector_type(4)));
typedef float f32x2 __attribute__((ext_vector_type(2)));
typedef unsigned u32x4 __attribute__((ext_vector_type(4)));
typedef unsigned u32x2 __attribute__((ext_vector_type(2)));

constexpr int NB = 16, SEQ = 4096, DM = 1024, MTOK = NB * SEQ, CTXL = 256, MCTX = NB * CTXL;
constexpr int GW = 64;
constexpr int CWID = 512, HWID = 512, HD = 128, NH = 4, CK = 31, CPAD = 15;
constexpr int NE = 16, FF = 1024, CAP = 512, NGRP = NB * NE, MROWS = NGRP * CAP;
constexpr int OFF_A = 0, OFF_B = 512, OFF_Q = 1024, OFF_I = 1536, OFF_FF = 2048, OFF_FB = 2560, OFF_G = 3072, INC = 3584;
constexpr int PCW = 1536;
constexpr int MODW = 6 * DM;
constexpr float EPS = 1e-6f;

constexpr size_t MiB = 1u << 20;
constexpr size_t WS_CTL = 0;
constexpr size_t WS_MOD = 1 * MiB;
constexpr size_t WS_LB = WS_MOD + 512 * 1024;
constexpr size_t WS_PROBS = 2 * MiB;
constexpr size_t WS_IDX = 6 * MiB;
constexpr size_t WS_GATE = 6 * MiB + 512 * 1024;
constexpr size_t WS_SEL = 7 * MiB;
constexpr size_t WS_WIN = 16 * MiB;
constexpr size_t WS_WOUT = 23 * MiB;
constexpr size_t WS_WGU = 25 * MiB;
constexpr size_t WS_WDN = 89 * MiB;
constexpr size_t WS_H = 128 * MiB;
constexpr size_t WS_H2 = 264 * MiB;
constexpr size_t WS_CPRE = 264 * MiB;
constexpr size_t WS_OF = 328 * MiB;
constexpr size_t WS_PROJ = 392 * MiB;
constexpr size_t WS_PCTX = 840 * MiB;
constexpr size_t WS_OB = 852 * MiB;
constexpr size_t WS_MOUT = 128 * MiB;
constexpr size_t WS_END = 916 * MiB;

constexpr int LDS_BYTES = 147456;
constexpr int NTHR = 512, NWAVES = 8;

struct Args {
    const float *x, *c, *ctx, *c_ctx, *ada_w, *ada_b, *norm1_g, *w_in, *taps, *conv_bias, *ln_g, *ln_b, *lb_logits, *hgrn_g, *w_out, *norm2_g, *router, *w_gate, *w_up, *w_down, *final_g;
    float* out; unsigned char* ws; int ph_lo, ph_hi;
};

DI float bf2f(bf16_t b) { return __uint_as_float(((unsigned)b) << 16); }
DI unsigned f2bf(float f) { unsigned u = __float_as_uint(f); return (u + 0x7fffu + ((u >> 16) & 1u)) >> 16; }
DI unsigned pk2(float lo, float hi) { return f2bf(lo) | (f2bf(hi) << 16); }
DI float bflo(unsigned w) { return __uint_as_float(w << 16); }
DI float bfhi(unsigned w) { return __uint_as_float(w & 0xffff0000u); }
DI float sigmoidf_(float x) { return 1.0f / (1.0f + __expf(-x)); }
DI float siluf_(float x) { return x / (1.0f + __expf(-x)); }
DI float wave_sum(float v) {
#pragma unroll
    for (int o = 1; o < 64; o <<= 1) v += __shfl_xor(v, o);
    return v;
}
DI unsigned cvt_pk_bf16(float lo, float hi) { unsigned r; asm volatile("v_cvt_pk_bf16_f32 %0, %1, %2" : "=v"(r) : "v"(lo), "v"(hi)); return r; }

namespace pg8 {
constexpr int BM = 256, BK = 64, HALF = 128, HTB = HALF * BK * 2, STAGE_BYTES = 8 * HTB, NXCD = 8, WGM = 8;
DI int lds_byte(int r, int c) { const int st = (r >> 4) * 2 + (c >> 5), rr = r & 15, cc = c & 31, ob = rr * 64 + cc * 2; return st * 1024 + (ob ^ (((ob >> 9) & 1) << 5)); }
DI void stage_rc(int b, int& R, int& C) { const int st = b / 1024, sb = b % 1024, swz = sb ^ (((sb >> 9) & 1) << 5); R = (st >> 1) * 16 + swz / 64; C = (st & 1) * 32 + (swz % 64) / 2; }
DI int perm32(int rho) { const int n = rho >> 4, i = rho & 15; return 8 * (i >> 2) + 4 * n + (i & 3); }
struct Unit { int pm, pn; };

struct TileOrder {
    int nM, nN, nwg, G, c;
    DI void init(int nM_, int nN_, int G_, int c_) { nM = nM_; nN = nN_; nwg = nM * nN; G = G_; c = c_; }
    DI bool next(int i, Unit& u) const {
        const long L = (long)i * G + c; if (L >= nwg) return false;
        int wgid = (int)L; { const int q = nwg / NXCD, r = nwg % NXCD, xcd = wgid % NXCD, off = wgid / NXCD; wgid = (xcd < r ? xcd * (q + 1) : r * (q + 1) + (xcd - r) * q) + off; }
        const int nig = WGM * nN, gid = wgid / nig, fm = gid * WGM, gsz = (nM - fm) < WGM ? (nM - fm) : WGM;
        u.pm = fm + ((wgid % nig) % gsz); u.pn = (wgid % nig) / gsz; return true;
    }
};

template <class Prob, class Epi, bool ALIGN_EPI, bool SP2>
DI void gemm_phase(LAS unsigned char* lds, const Prob& P, const Epi& E) {
    const int tid = threadIdx.x, wid = __builtin_amdgcn_readfirstlane(tid >> 6), lane = tid & 63, wr = wid >> 2, wc = wid & 3, fr = lane & 15, fq = lane >> 4;
    const int K = P.K, nt = K / BK;
    int Rr[2], Cc[2]; unsigned voffB[2];
#pragma unroll
    for (int i = 0; i < 2; ++i) { int R, C; stage_rc(tid * 16 + i * 8192, R, C); Rr[i] = R; Cc[i] = C; const int Rb = Epi::PERM ? ((R & ~31) + perm32(R & 31)) : R; voffB[i] = (unsigned)(Rb * K + C) * 2u; }
    const unsigned kstep = (unsigned)(BK * 2);
    const size_t hstep = (size_t)HALF * K * 2;
    const unsigned ldsw = (unsigned)wid * 1024u;
    const int aoff = lds_byte(wr * 64 + fr, fq * 8), boff = lds_byte(wc * 32 + fr, fq * 8);
#define PG8_SA(b, h) (((b) * 2 + (h)) * HTB)
#define PG8_SB(b, h) ((4 + (b) * 2 + (h)) * HTB)
#define PG8_STAGE(bufoff, gbase, voff) do { _Pragma("unroll") for (int _i = 0; _i < 2; ++_i) \
        __builtin_amdgcn_global_load_lds((const unsigned*)((const char*)(gbase) + (voff)[_i]), (LAS unsigned*)(lds + (bufoff) + ldsw + _i * 8192), 16, 0, 0); } while (0)
#define PG8_LDA(dst, b, h) do { _Pragma("unroll") for (int m = 0; m < 4; ++m) _Pragma("unroll") for (int k = 0; k < 2; ++k) dst[m][k] = *(const LAS bf16x8*)(lds + PG8_SA(b, h) + aoff + m * 2048 + k * 1024); } while (0)
#define PG8_LDB(dst, b, h) do { _Pragma("unroll") for (int n = 0; n < 2; ++n) _Pragma("unroll") for (int k = 0; k < 2; ++k) dst[n][k] = *(const LAS bf16x8*)(lds + PG8_SB(b, h) + boff + n * 2048 + k * 1024); } while (0)
#define PG8_MMA(ai, bj, At, Bt) do { __builtin_amdgcn_s_setprio(1); _Pragma("unroll") for (int m = 0; m < 4; ++m) _Pragma("unroll") for (int n = 0; n < 2; ++n) _Pragma("unroll") for (int k = 0; k < 2; ++k) \
        acc[ai][bj][m][n] = __builtin_amdgcn_mfma_f32_16x16x32_bf16(Bt[n][k], At[m][k], acc[ai][bj][m][n], 0, 0, 0); __builtin_amdgcn_s_setprio(0); } while (0)
#define PG8_WAIT_V(n) asm volatile("s_waitcnt vmcnt(" #n ")" ::: "memory")
#define PG8_WAIT_L(n) asm volatile("s_waitcnt lgkmcnt(" #n ")" ::: "memory")
#define PG8_BAR __builtin_amdgcn_s_barrier()
#define PG8_SCHED __builtin_amdgcn_sched_barrier(0)
    Unit cur, nxt; int ui = 0;
    if (!P.next(0, cur)) return;
    f32x4 acc[2][2][4][2];
#pragma unroll
    for (int a = 0; a < 2; ++a)
#pragma unroll
        for (int b = 0; b < 2; ++b)
#pragma unroll
            for (int m = 0; m < 4; ++m)
#pragma unroll
                for (int n = 0; n < 2; ++n) acc[a][b][m][n] = (f32x4){0.f, 0.f, 0.f, 0.f};
    bf16x8 At[4][2], B0[2][2], B1[2][2];
    unsigned vA[2][2], vAn[2][2];
    P.a_voff(cur, Rr, Cc, vA);
    const char* const Ab = (const char*)P.a_base();
    const char* cB = (const char*)P.b_base(cur);
    if constexpr (SP2) {
        PG8_STAGE(PG8_SB(0, 0), cB, voffB); PG8_STAGE(PG8_SB(0, 1), cB + hstep, voffB); PG8_STAGE(PG8_SA(0, 0), Ab, vA[0]); PG8_STAGE(PG8_SA(0, 1), Ab, vA[1]);
        if (wr == 1) PG8_BAR;
        PG8_WAIT_V(2); PG8_BAR;
        PG8_STAGE(PG8_SB(1, 0), cB + kstep, voffB); PG8_STAGE(PG8_SA(1, 0), Ab + kstep, vA[0]); PG8_STAGE(PG8_SB(1, 1), cB + hstep + kstep, voffB);
        PG8_WAIT_V(6); PG8_BAR;
    } else {
        PG8_STAGE(PG8_SB(0, 0), cB, voffB); PG8_STAGE(PG8_SA(0, 0), Ab, vA[0]); PG8_STAGE(PG8_SB(0, 1), cB + hstep, voffB); PG8_STAGE(PG8_SA(0, 1), Ab, vA[1]);
        if (wr == 1) PG8_BAR;
        PG8_WAIT_V(4); PG8_BAR;
        PG8_STAGE(PG8_SB(1, 0), cB + kstep, voffB); PG8_STAGE(PG8_SA(1, 0), Ab + kstep, vA[0]); PG8_STAGE(PG8_SB(1, 1), cB + hstep + kstep, voffB);
        PG8_WAIT_V(6); PG8_BAR;
    }
    for (;;) {
        const bool has_next = P.next(ui + 1, nxt);
        const char* nB = cB;
        if (has_next) { P.a_voff(nxt, Rr, Cc, vAn); nB = (const char*)P.b_base(nxt); }
        else {
#pragma unroll
            for (int h = 0; h < 2; ++h)
#pragma unroll
                for (int i = 0; i < 2; ++i) vAn[h][i] = vA[h][i];
        }
        for (int t = 0; t < nt; t += 2) {
            const bool last = (t == nt - 2);
            const char* a1 = Ab + (size_t)(t + 1) * kstep;
            const char* a2 = last ? Ab : Ab + (size_t)(t + 2) * kstep; const char* b2 = last ? nB : cB + (size_t)(t + 2) * kstep;
            const char* a3 = a2 + kstep; const char* b3 = b2 + kstep;
            unsigned v2[2][2];
#pragma unroll
            for (int h = 0; h < 2; ++h)
#pragma unroll
                for (int i = 0; i < 2; ++i) v2[h][i] = last ? vAn[h][i] : vA[h][i];
            if constexpr (SP2) {
            PG8_LDB(B0, 0, 0); PG8_LDB(B1, 0, 1); PG8_SCHED; PG8_LDA(At, 0, 0); PG8_STAGE(PG8_SA(1, 1), a1, vA[1]);
            PG8_WAIT_V(8); PG8_WAIT_L(0); PG8_BAR; PG8_MMA(0, 0, At, B0); PG8_MMA(0, 1, At, B1); PG8_BAR; PG8_SCHED;
            PG8_LDA(At, 0, 1); PG8_STAGE(PG8_SB(0, 0), b2, voffB); PG8_STAGE(PG8_SB(0, 1), b2 + hstep, voffB); PG8_STAGE(PG8_SA(0, 0), a2, v2[0]);
            PG8_WAIT_V(8); PG8_WAIT_L(0); PG8_BAR; PG8_MMA(1, 0, At, B0); PG8_MMA(1, 1, At, B1); PG8_BAR; PG8_SCHED;
            PG8_LDB(B0, 1, 0); PG8_LDB(B1, 1, 1); PG8_SCHED; PG8_LDA(At, 1, 0); PG8_STAGE(PG8_SA(0, 1), a2, v2[1]);
            PG8_WAIT_V(8); PG8_WAIT_L(0); PG8_BAR; PG8_MMA(0, 0, At, B0); PG8_MMA(0, 1, At, B1); PG8_BAR; PG8_SCHED;
            PG8_LDA(At, 1, 1); PG8_STAGE(PG8_SB(1, 0), b3, voffB); PG8_STAGE(PG8_SB(1, 1), b3 + hstep, voffB); PG8_STAGE(PG8_SA(1, 0), a3, v2[0]);
            PG8_WAIT_V(8); PG8_WAIT_L(0); PG8_BAR; PG8_MMA(1, 0, At, B0); PG8_MMA(1, 1, At, B1); PG8_BAR; PG8_SCHED;
            } else {
            PG8_LDB(B0, 0, 0); PG8_SCHED; PG8_LDA(At, 0, 0); PG8_STAGE(PG8_SA(1, 1), a1, vA[1]);
            PG8_WAIT_L(8); PG8_BAR; PG8_WAIT_L(0); PG8_MMA(0, 0, At, B0); PG8_BAR; PG8_SCHED;
            PG8_LDB(B1, 0, 1); PG8_STAGE(PG8_SB(0, 0), b2, voffB);
            PG8_BAR; PG8_WAIT_L(0); PG8_MMA(0, 1, At, B1); PG8_BAR;
            PG8_LDA(At, 0, 1); PG8_STAGE(PG8_SA(0, 0), a2, v2[0]);
            PG8_BAR; PG8_WAIT_L(0); PG8_MMA(1, 0, At, B0); PG8_BAR; PG8_SCHED;
            PG8_STAGE(PG8_SB(0, 1), b2 + hstep, voffB);
            PG8_WAIT_V(6); PG8_BAR; PG8_MMA(1, 1, At, B1); PG8_BAR;
            PG8_LDB(B0, 1, 0); PG8_SCHED; PG8_LDA(At, 1, 0); PG8_STAGE(PG8_SA(0, 1), a2, v2[1]);
            PG8_WAIT_L(8); PG8_BAR; PG8_WAIT_L(0); PG8_MMA(0, 0, At, B0); PG8_BAR; PG8_SCHED;
            PG8_LDB(B1, 1, 1); PG8_STAGE(PG8_SB(1, 0), b3, voffB);
            PG8_BAR; PG8_WAIT_L(0); PG8_MMA(0, 1, At, B1); PG8_BAR;
            PG8_LDA(At, 1, 1); PG8_STAGE(PG8_SA(1, 0), a3, v2[0]);
            PG8_BAR; PG8_WAIT_L(0); PG8_MMA(1, 0, At, B0); PG8_BAR; PG8_SCHED;
            PG8_STAGE(PG8_SB(1, 1), b3 + hstep, voffB);
            PG8_WAIT_V(6); PG8_BAR; PG8_MMA(1, 1, At, B1); PG8_BAR;
            }
        }
        if constexpr (ALIGN_EPI) { if (wr == 0) PG8_BAR; }
        E(acc, cur, wr, wc, fr, fq);
        if (!has_next) break;
#pragma unroll
        for (int a = 0; a < 2; ++a)
#pragma unroll
            for (int b = 0; b < 2; ++b)
#pragma unroll
                for (int m = 0; m < 4; ++m)
#pragma unroll
                    for (int n = 0; n < 2; ++n) acc[a][b][m][n] = (f32x4){0.f, 0.f, 0.f, 0.f};
        cur = nxt; cB = nB; ++ui;
#pragma unroll
        for (int h = 0; h < 2; ++h)
#pragma unroll
            for (int i = 0; i < 2; ++i) vA[h][i] = vAn[h][i];
        if constexpr (ALIGN_EPI) { if (wr == 1) PG8_BAR; }
    }
    PG8_WAIT_V(0);
    if constexpr (!ALIGN_EPI) { if (wr == 0) PG8_BAR; }
    PG8_BAR;
#undef PG8_SA
#undef PG8_SB
#undef PG8_STAGE
#undef PG8_LDA
#undef PG8_LDB
#undef PG8_MMA
#undef PG8_WAIT_V
#undef PG8_WAIT_L
#undef PG8_BAR
#undef PG8_SCHED
}
}
using pg8::Unit;

struct ProbDense {
    const bf16_t* A; const bf16_t* Bt; int K; pg8::TileOrder ord;
    DI bool next(int i, Unit& u) const { return ord.next(i, u); }
    DI const void* a_base() const { return A; }
    DI const void* b_base(const Unit& u) const { return Bt + (size_t)u.pn * 256 * K; }
    DI void a_voff(const Unit& u, const int (&R)[2], const int (&C)[2], unsigned (&v)[2][2]) const {
#pragma unroll
        for (int h = 0; h < 2; ++h)
#pragma unroll
            for (int i = 0; i < 2; ++i) v[h][i] = (unsigned)(((u.pm * 256 + h * 128 + R[i]) * K + C[i]) * 2);
    }
};
DI void moe_unit(int pmv, int& g, int& half, int& e) { e = pmv >> 5; const int b = (pmv >> 1) & 15; half = pmv & 1; g = b * NE + e; }
struct ProbMoeUp {
    const bf16_t* A; const bf16_t* Bt; const int* idx; int K; pg8::TileOrder ord;
    DI bool next(int i, Unit& u) const { return ord.next(i, u); }
    DI const void* a_base() const { return A; }
    DI const void* b_base(const Unit& u) const { int g, half, e; moe_unit(u.pm, g, half, e); return Bt + ((size_t)e * 2048 + (size_t)u.pn * 256) * K; }
    DI void a_voff(const Unit& u, const int (&R)[2], const int (&C)[2], unsigned (&v)[2][2]) const {
        int g, half, e; moe_unit(u.pm, g, half, e); const int b = g >> 4;
#pragma unroll
        for (int h = 0; h < 2; ++h)
#pragma unroll
            for (int i = 0; i < 2; ++i) { const int tok = idx[g * CAP + half * 256 + h * 128 + R[i]]; v[h][i] = (unsigned)(((b * SEQ + tok) * K + C[i]) * 2); }
    }
};
struct ProbMoeDown {
    const bf16_t* A; const bf16_t* Bt; int K; pg8::TileOrder ord;
    DI bool next(int i, Unit& u) const { return ord.next(i, u); }
    DI const void* a_base() const { return A; }
    DI const void* b_base(const Unit& u) const { int g, half, e; moe_unit(u.pm, g, half, e); return Bt + ((size_t)e * 1024 + (size_t)u.pn * 256) * K; }
    DI void a_voff(const Unit& u, const int (&R)[2], const int (&C)[2], unsigned (&v)[2][2]) const {
        int g, half, e; moe_unit(u.pm, g, half, e);
#pragma unroll
        for (int h = 0; h < 2; ++h)
#pragma unroll
            for (int i = 0; i < 2; ++i) v[h][i] = (unsigned)(((g * CAP + half * 256 + h * 128 + R[i]) * K + C[i]) * 2);
    }
};

struct EpiBf16 {
    static constexpr bool PERM = true;
    bf16_t* O; int ldc;
    DI void operator()(const f32x4 (&acc)[2][2][4][2], const Unit& u, int wr, int wc, int fr, int fq) const {
        const int row0 = u.pm * 256 + wr * 64 + fr, col0 = u.pn * 256 + wc * 32 + 8 * fq;
#pragma unroll
        for (int ai = 0; ai < 2; ++ai)
#pragma unroll
            for (int m = 0; m < 4; ++m) { bf16_t* rowp = O + (size_t)(row0 + ai * 128 + m * 16) * ldc + col0;
#pragma unroll
                for (int bj = 0; bj < 2; ++bj) { const f32x4 v0 = acc[ai][bj][m][0], v1 = acc[ai][bj][m][1];
                    u32x4 w; w.x = cvt_pk_bf16(v0[0], v0[1]); w.y = cvt_pk_bf16(v0[2], v0[3]); w.z = cvt_pk_bf16(v1[0], v1[1]); w.w = cvt_pk_bf16(v1[2], v1[3]);
                    *(u32x4*)(rowp + bj * 128) = w; } }
    }
};
struct EpiX1 {
    static constexpr bool PERM = false;
    const float* x; const float* mod; float* out;
    DI void operator()(const f32x4 (&acc)[2][2][4][2], const Unit& u, int wr, int wc, int fr, int fq) const {
        const int row0 = u.pm * 256 + wr * 64 + fr, col0 = u.pn * 256 + wc * 32 + 4 * fq;
        const float* g1 = mod + (size_t)(u.pm >> 4) * MODW + 2 * DM;
        f32x4 gv[2][2];
#pragma unroll
        for (int bj = 0; bj < 2; ++bj)
#pragma unroll
            for (int n = 0; n < 2; ++n) gv[bj][n] = *(const f32x4*)(g1 + col0 + bj * 128 + n * 16);
#pragma unroll
        for (int ai = 0; ai < 2; ++ai)
#pragma unroll
            for (int m = 0; m < 4; ++m) { const size_t off = (size_t)(row0 + ai * 128 + m * 16) * DM + col0;
#pragma unroll
                for (int bj = 0; bj < 2; ++bj)
#pragma unroll
                    for (int n = 0; n < 2; ++n) { const f32x4 xv = *(const f32x4*)(x + off + bj * 128 + n * 16);
                        *(f32x4*)(out + off + bj * 128 + n * 16) = xv + gv[bj][n] * acc[ai][bj][m][n]; } }
    }
};
struct EpiSwiglu {
    static constexpr bool PERM = true;
    bf16_t* hid;
    DI void operator()(const f32x4 (&acc)[2][2][4][2], const Unit& u, int wr, int wc, int fr, int fq) const {
        int g, half, e; moe_unit(u.pm, g, half, e);
        const int row0 = g * CAP + half * 256 + wr * 64 + fr, col0 = u.pn * 128 + wc * 32 + 8 * fq;
#pragma unroll
        for (int ai = 0; ai < 2; ++ai)
#pragma unroll
            for (int m = 0; m < 4; ++m) { bf16_t* rowp = hid + (size_t)(row0 + ai * 128 + m * 16) * FF + col0;
                float r[8];
#pragma unroll
                for (int n = 0; n < 2; ++n)
#pragma unroll
                    for (int j = 0; j < 4; ++j) { const float gt = acc[ai][0][m][n][j], up = acc[ai][1][m][n][j]; r[n * 4 + j] = siluf_(gt) * up; }
                u32x4 w; w.x = cvt_pk_bf16(r[0], r[1]); w.y = cvt_pk_bf16(r[2], r[3]); w.z = cvt_pk_bf16(r[4], r[5]); w.w = cvt_pk_bf16(r[6], r[7]);
                *(u32x4*)rowp = w; }
    }
};
struct EpiDown {
    static constexpr bool PERM = true;
    bf16_t* O; const float* gate;
    DI void operator()(const f32x4 (&acc)[2][2][4][2], const Unit& u, int wr, int wc, int fr, int fq) const {
        int g, half, e; moe_unit(u.pm, g, half, e);
        const int row0 = g * CAP + half * 256 + wr * 64 + fr, col0 = u.pn * 256 + wc * 32 + 8 * fq;
#pragma unroll
        for (int ai = 0; ai < 2; ++ai)
#pragma unroll
            for (int m = 0; m < 4; ++m) { const int row = row0 + ai * 128 + m * 16; const float gt = gate[row]; bf16_t* rowp = O + (size_t)row * DM + col0;
#pragma unroll
                for (int bj = 0; bj < 2; ++bj) { const f32x4 v0 = acc[ai][bj][m][0] * gt, v1 = acc[ai][bj][m][1] * gt;
                    u32x4 w; w.x = cvt_pk_bf16(v0[0], v0[1]); w.y = cvt_pk_bf16(v0[2], v0[3]); w.z = cvt_pk_bf16(v1[0], v1[1]); w.w = cvt_pk_bf16(v1[2], v1[3]);
                    *(u32x4*)(rowp + bj * 128) = w; } }
    }
};

struct Frame {
    LAS unsigned char* lds; int tid, lane, wave, blk, nblk;
    Args a;
    float* mod; float* lb; float* probs; int* idx; float* gate; int* sel;
    bf16_t *win, *wout, *wgu, *wdn, *h, *mixed, *h2, *cpre, *of, *ob, *proj, *pctx, *hid, *mout;
};

DI void transpose_item(const float* W, int K, int N, bf16_t* WT, int k0, int n0, int drow0, LAS float* scr, int lane) {
#pragma unroll 8
    for (int i = 0; i < 32; ++i) { const int kk = 2 * i + (lane >> 5); scr[kk * 33 + (lane & 31)] = W[(size_t)(k0 + kk) * N + n0 + (lane & 31)]; }
    asm volatile("s_waitcnt lgkmcnt(0)" ::: "memory");
    const int c = lane & 7;
#pragma unroll
    for (int j = 0; j < 4; ++j) { const int n = (lane >> 3) + 8 * j; const LAS float* s = scr + (8 * c) * 33 + n;
        u32x4 o; o.x = pk2(s[0 * 33], s[1 * 33]); o.y = pk2(s[2 * 33], s[3 * 33]); o.z = pk2(s[4 * 33], s[5 * 33]); o.w = pk2(s[6 * 33], s[7 * 33]);
        *(u32x4*)(WT + (size_t)(drow0 + n) * K + k0 + 8 * c) = o; }
    asm volatile("s_waitcnt lgkmcnt(0)" ::: "memory");
}
DI void p0_prologue(Frame& F) {
    const Args& A = F.a;
    {
        LAS float* scr = (LAS float*)(F.lds + F.wave * 16384);
        const int gw = F.blk * NWAVES + F.wave, ngw = F.nblk * NWAVES;
        constexpr int I_IN = 16 * (INC / 32), I_OUT = 16 * 32, I_E = 16 * 32;
        constexpr int NIT = I_IN + I_OUT + NE * 3 * I_E;
        for (int it = gw; it < NIT; it += ngw) {
            int r = it;
            if (r < I_IN) { const int nb = r % (INC / 32), kb = r / (INC / 32); transpose_item(A.w_in, DM, INC, F.win, kb * 64, nb * 32, nb * 32, scr, F.lane); continue; } r -= I_IN;
            if (r < I_OUT) { const int nb = r % 32, kb = r / 32; transpose_item(A.w_out, DM, DM, F.wout, kb * 64, nb * 32, nb * 32, scr, F.lane); continue; } r -= I_OUT;
            const int e = r / (3 * I_E), q = r % (3 * I_E), which = q / I_E, rr = q % I_E, nb = rr % 32, kb = rr / 32, n0 = nb * 32;
            if (which == 0) transpose_item(A.w_gate + (size_t)e * DM * FF, DM, FF, F.wgu + (size_t)e * 2048 * DM, kb * 64, n0, (n0 >> 7) * 256 + (n0 & 127), scr, F.lane);
            else if (which == 1) transpose_item(A.w_up + (size_t)e * DM * FF, DM, FF, F.wgu + (size_t)e * 2048 * DM, kb * 64, n0, (n0 >> 7) * 256 + 128 + (n0 & 127), scr, F.lane);
            else transpose_item(A.w_down + (size_t)e * FF * DM, FF, DM, F.wdn + (size_t)e * DM * FF, kb * 64, n0, n0, scr, F.lane);
        }
    }
    __syncthreads();
    {
        LAS float* sm = (LAS float*)F.lds;
        for (int i = F.tid; i < 17 * DM; i += NTHR) { const int v = i >> 10, k = i & 1023; const float xv = v < 16 ? A.c[v * DM + k] : A.c_ctx[k]; sm[i] = siluf_(xv); }
        __syncthreads();
        LAS float* red = sm + 17 * DM;
        for (int chunk = F.blk; chunk < MODW / 24; chunk += F.nblk) {
            const int col = F.tid % 24, kg = F.tid / 24;
            float acc[17];
#pragma unroll
            for (int v = 0; v < 17; ++v) acc[v] = 0.f;
            if (kg < 21) {
                for (int k = kg; k < DM; k += 21) { const float w = A.ada_w[(size_t)k * MODW + chunk * 24 + col];
#pragma unroll
                    for (int v = 0; v < 17; ++v) acc[v] += sm[v * DM + k] * w; }
#pragma unroll
                for (int v = 0; v < 17; ++v) red[(kg * 17 + v) * 24 + col] = acc[v];
            }
            __syncthreads();
            if (F.tid < 17 * 24) { const int v = F.tid / 24, cc = F.tid % 24; float s = A.ada_b[chunk * 24 + cc];
                for (int g = 0; g < 21; ++g) s += red[(g * 17 + v) * 24 + cc];
                F.mod[v * MODW + chunk * 24 + cc] = s; }
            __syncthreads();
        }
    }
    if (F.blk == 0) for (int i = F.tid; i < 2 * HWID; i += NTHR) { const float l0 = A.lb_logits[i], l1 = A.lb_logits[2 * HWID + i]; F.lb[i] = 1.0f / (1.0f + __expf(l1 - l0)); }
}

DI void p1_rows(Frame& F) {
    const Args& A = F.a; const int gw = F.blk * NWAVES + F.wave, ngw = F.nblk * NWAVES, lane = F.lane;
    for (int r = gw; r < MTOK + MCTX; r += ngw) {
        const float* src; int v;
        if (r < MTOK) { src = A.x + (size_t)r * DM; v = r >> 12; } else { src = A.ctx + (size_t)(r - MTOK) * DM; v = 16; }
        const float* md = F.mod + (size_t)v * MODW;
        f32x4 xv[4]; float ss = 0.f;
#pragma unroll
        for (int j = 0; j < 4; ++j) { xv[j] = *(const f32x4*)(src + 4 * lane + 256 * j); ss += (xv[j].x * xv[j].x + xv[j].y * xv[j].y) + (xv[j].z * xv[j].z + xv[j].w * xv[j].w); }
        const float rstd = rsqrtf(wave_sum(ss) * (1.0f / DM) + EPS);
        bf16_t* dst = F.h + (size_t)r * DM;
#pragma unroll
        for (int j = 0; j < 4; ++j) { const int col = 4 * lane + 256 * j;
            const f32x4 g = *(const f32x4*)(A.norm1_g + col), sc = *(const f32x4*)(md + DM + col), sh = *(const f32x4*)(md + col);
            const f32x4 y = xv[j] * rstd * g * (sc + 1.0f) + sh;
            u32x2 w; w.x = pk2(y.x, y.y); w.y = pk2(y.z, y.w); *(u32x2*)(dst + col) = w; }
    }
}

template <int P0, int N> DI void conv_out(const f32x2 (&u)[64], const f32x2 (&tp)[CK], const f32x2 bias, bf16_t* dst, const size_t dstride) {
    if constexpr (N == 1) {
        f32x2 s = bias;
#pragma unroll
        for (int k = 0; k < CK; ++k) { const int q = P0 + k - CPAD; if (q >= 0 && q < 64) s += tp[k] * u[q]; }
        *(unsigned*)(dst + (size_t)P0 * dstride) = pk2(s.x, s.y);
    } else { conv_out<P0, N / 2>(u, tp, bias, dst, dstride); conv_out<P0 + N / 2, N - N / 2>(u, tp, bias, dst, dstride); }
}
DI void conv_item(Frame& F, int item) {
    const Args& A = F.a; const int lane = F.lane;
    const int cg2 = item & 1, line = (item >> 1) & 1023, axis = item >> 11;
    const int b = line >> 6, l = line & 63;
    const int ch = axis * 256 + cg2 * 128 + 2 * lane;
    const int tok0 = b * SEQ + (axis == 0 ? l * GW : l), tstride = (axis == 0 ? 1 : GW);
    f32x2 u[64];
#pragma unroll
    for (int p = 0; p < 64; ++p) { const bf16_t* pr = F.proj + (size_t)(tok0 + p * tstride) * INC + ch;
        const unsigned av = *(const unsigned*)(pr + OFF_A), bv = *(const unsigned*)(pr + OFF_B);
        u[p].x = bflo(av) * sigmoidf_(bflo(bv)); u[p].y = bfhi(av) * sigmoidf_(bfhi(bv)); }
    f32x2 tp[CK];
#pragma unroll
    for (int k = 0; k < CK; ++k) tp[k] = *(const f32x2*)(A.taps + k * CWID + ch);
    const f32x2 bias = *(const f32x2*)(A.conv_bias + ch);
    conv_out<0, 64>(u, tp, bias, F.cpre + (size_t)tok0 * CWID + ch, (size_t)tstride * CWID);
}

DI void scan_naive_item(Frame& F, int item) {
    const int dir = item & 1, hh = (item >> 1) & 3, b = item >> 3;
    const int tid = F.tid, v = tid >> 2, kq = tid & 3;
    LAS float* qs = (LAS float*)F.lds; LAS float* fs = qs + 32 * 128; LAS float* ks = fs + 32 * 128; LAS float* vs = ks + 32 * 128; LAS float* os = vs + 32 * 128;
    float S[32];
#pragma unroll
    for (int i = 0; i < 32; ++i) S[i] = 0.f;
    const float* lbp = F.lb + dir * HWID + hh * HD;
    for (int ch = 0; ch < CTXL / 32; ++ch) {
        __syncthreads();
#pragma unroll
        for (int j = 0; j < 8; ++j) { const int e = tid + NTHR * j, t = e >> 7, k = e & 127, pos = ch * 32 + t, n = dir ? (CTXL - 1 - pos) : pos;
            const bf16_t* pr = F.pctx + (size_t)(b * CTXL + n) * PCW + hh * HD + k;
            const float vi = bf2f(pr[0]), fl = bf2f(pr[HWID + dir * HWID]); const float lbk = lbp[k];
            const float f = lbk + (1.0f - lbk) * sigmoidf_(fl);
            fs[e] = f; ks[e] = 1.0f - f; vs[e] = vi; }
        __syncthreads();
        for (int t = 0; t < 32; ++t) { const float vv = vs[t * 128 + v];
#pragma unroll
            for (int i4 = 0; i4 < 8; ++i4) { const f32x4 f4 = *(const LAS f32x4*)(fs + t * 128 + kq * 32 + i4 * 4), k4 = *(const LAS f32x4*)(ks + t * 128 + kq * 32 + i4 * 4);
#pragma unroll
                for (int j = 0; j < 4; ++j) S[i4 * 4 + j] = f4[j] * S[i4 * 4 + j] + k4[j] * vv; } }
    }
    bf16_t* obase = dir ? F.ob : F.of;
    const int foff = dir ? OFF_FB : OFF_FF;
    for (int ch = 0; ch < SEQ / 32; ++ch) {
        __syncthreads();
#pragma unroll
        for (int j = 0; j < 8; ++j) { const int e = tid + NTHR * j, t = e >> 7, k = e & 127, pos = ch * 32 + t, n = dir ? (SEQ - 1 - pos) : pos;
            const bf16_t* pr = F.proj + (size_t)(b * SEQ + n) * INC + hh * HD + k;
            const float qv = bf2f(pr[OFF_Q]), vi = bf2f(pr[OFF_I]), fl = bf2f(pr[foff]); const float lbk = lbp[k];
            const float f = lbk + (1.0f - lbk) * sigmoidf_(fl);
            qs[e] = qv; fs[e] = f; ks[e] = 1.0f - f; vs[e] = vi; }
        __syncthreads();
        for (int t = 0; t < 32; ++t) { const float vv = vs[t * 128 + v]; float o = 0.f;
#pragma unroll
            for (int i4 = 0; i4 < 8; ++i4) { const f32x4 f4 = *(const LAS f32x4*)(fs + t * 128 + kq * 32 + i4 * 4), k4 = *(const LAS f32x4*)(ks + t * 128 + kq * 32 + i4 * 4), q4 = *(const LAS f32x4*)(qs + t * 128 + kq * 32 + i4 * 4);
#pragma unroll
                for (int j = 0; j < 4; ++j) { S[i4 * 4 + j] = f4[j] * S[i4 * 4 + j] + k4[j] * vv; o += q4[j] * S[i4 * 4 + j]; } }
            o += __shfl_xor(o, 1); o += __shfl_xor(o, 2);
            if (kq == 0) os[t * 128 + v] = o; }
        __syncthreads();
#pragma unroll
        for (int j = 0; j < 4; ++j) { const int e2 = tid + NTHR * j, t = e2 >> 6, vp = (e2 & 63) * 2, pos = ch * 32 + t, n = dir ? (SEQ - 1 - pos) : pos;
            *(unsigned*)(obase + (size_t)(b * SEQ + n) * HWID + hh * HD + vp) = pk2(os[t * 128 + vp], os[t * 128 + vp + 1]); }
    }
}

DI void p4_mixed(Frame& F) {
    const Args& A = F.a; const int gw = F.blk * NWAVES + F.wave, ngw = F.nblk * NWAVES, lane = F.lane;
    for (int tok = gw; tok < MTOK; tok += ngw) {
        const u32x4 cw = *(const u32x4*)(F.cpre + (size_t)tok * CWID + 8 * lane);
        float cv[8] = {bflo(cw.x), bfhi(cw.x), bflo(cw.y), bfhi(cw.y), bflo(cw.z), bfhi(cw.z), bflo(cw.w), bfhi(cw.w)};
        float s = 0.f;
#pragma unroll
        for (int j = 0; j < 8; ++j) s += cv[j];
        const float mu = wave_sum(s) * (1.0f / CWID); float q = 0.f;
#pragma unroll
        for (int j = 0; j < 8; ++j) { cv[j] -= mu; q += cv[j] * cv[j]; }
        const float rstd = rsqrtf(wave_sum(q) * (1.0f / CWID) + EPS);
        float r[8];
#pragma unroll
        for (int j = 0; j < 8; ++j) { const float y = cv[j] * rstd * A.ln_g[8 * lane + j] + A.ln_b[8 * lane + j]; r[j] = siluf_(y); }
        u32x4 w; w.x = pk2(r[0], r[1]); w.y = pk2(r[2], r[3]); w.z = pk2(r[4], r[5]); w.w = pk2(r[6], r[7]);
        *(u32x4*)(F.mixed + (size_t)tok * DM + 8 * lane) = w;
        const u32x4 fw = *(const u32x4*)(F.of + (size_t)tok * HWID + 8 * lane), bw = *(const u32x4*)(F.ob + (size_t)tok * HWID + 8 * lane);
        const u32x4 gw4 = *(const u32x4*)(F.proj + (size_t)tok * INC + OFF_G + 8 * lane);
        float o[8] = {bflo(fw.x) + bflo(bw.x), bfhi(fw.x) + bfhi(bw.x), bflo(fw.y) + bflo(bw.y), bfhi(fw.y) + bfhi(bw.y), bflo(fw.z) + bflo(bw.z), bfhi(fw.z) + bfhi(bw.z), bflo(fw.w) + bflo(bw.w), bfhi(fw.w) + bfhi(bw.w)};
        const float gt[8] = {bflo(gw4.x), bfhi(gw4.x), bflo(gw4.y), bfhi(gw4.y), bflo(gw4.z), bfhi(gw4.z), bflo(gw4.w), bfhi(gw4.w)};
        float ss = 0.f;
#pragma unroll
        for (int j = 0; j < 8; ++j) ss += o[j] * o[j];
        ss += __shfl_xor(ss, 1); ss += __shfl_xor(ss, 2); ss += __shfl_xor(ss, 4); ss += __shfl_xor(ss, 8);
        const float rs = rsqrtf(ss * (1.0f / HD) + EPS);
#pragma unroll
        for (int j = 0; j < 8; ++j) r[j] = o[j] * rs * A.hgrn_g[8 * lane + j] * siluf_(gt[j]);
        w.x = pk2(r[0], r[1]); w.y = pk2(r[2], r[3]); w.z = pk2(r[4], r[5]); w.w = pk2(r[6], r[7]);
        *(u32x4*)(F.mixed + (size_t)tok * DM + CWID + 8 * lane) = w;
    }
}

DI void p6_rows(Frame& F) {
    const Args& A = F.a; const int gw = F.blk * NWAVES + F.wave, ngw = F.nblk * NWAVES, lane = F.lane;
    LAS float* rw = (LAS float*)F.lds;
    for (int i = F.tid; i < DM * NE / 4; i += NTHR) *(LAS f32x4*)(rw + 4 * i) = *(const f32x4*)(A.router + 4 * i);
    __syncthreads();
    for (int tok = gw; tok < MTOK; tok += ngw) {
        const int b = tok >> 12; const float* md = F.mod + (size_t)b * MODW; const float* src = A.out + (size_t)tok * DM;
        f32x4 xv[4]; float ss = 0.f;
#pragma unroll
        for (int j = 0; j < 4; ++j) { xv[j] = *(const f32x4*)(src + 4 * lane + 256 * j); ss += (xv[j].x * xv[j].x + xv[j].y * xv[j].y) + (xv[j].z * xv[j].z + xv[j].w * xv[j].w); }
        const float rstd = rsqrtf(wave_sum(ss) * (1.0f / DM) + EPS);
        float lg[NE];
#pragma unroll
        for (int e = 0; e < NE; ++e) lg[e] = 0.f;
        bf16_t* dst = F.h2 + (size_t)tok * DM;
#pragma unroll
        for (int j = 0; j < 4; ++j) { const int col = 4 * lane + 256 * j;
            const f32x4 g = *(const f32x4*)(A.norm2_g + col), sc = *(const f32x4*)(md + 4 * DM + col), sh = *(const f32x4*)(md + 3 * DM + col);
            const f32x4 y = xv[j] * rstd * g * (sc + 1.0f) + sh;
            u32x2 w; w.x = pk2(y.x, y.y); w.y = pk2(y.z, y.w); *(u32x2*)(dst + col) = w;
#pragma unroll
            for (int cc = 0; cc < 4; ++cc) {
#pragma unroll
                for (int e4 = 0; e4 < 4; ++e4) { const f32x4 r4 = *(const LAS f32x4*)(rw + (col + cc) * NE + e4 * 4);
#pragma unroll
                    for (int q = 0; q < 4; ++q) lg[e4 * 4 + q] += y[cc] * r4[q]; }
                asm volatile("" ::: "memory"); } }
        float mx = -3.0e38f;
#pragma unroll
        for (int e = 0; e < NE; ++e) { lg[e] = wave_sum(lg[e]); mx = fmaxf(mx, lg[e]); }
        float den = 0.f;
#pragma unroll
        for (int e = 0; e < NE; ++e) { lg[e] = __expf(lg[e] - mx); den += lg[e]; }
        const float inv = 1.0f / den; float mine = 0.f;
#pragma unroll
        for (int e = 0; e < NE; ++e) mine = (lane == e) ? lg[e] * inv : mine;
        if (lane < NE) F.probs[((size_t)(b * NE + lane)) * SEQ + (tok & (SEQ - 1))] = mine;
    }
}

DI void topk_item(Frame& F, int g) {
    const int tid = F.tid, lane = F.lane, wave = F.wave;
    LAS int* hist = (LAS int*)F.lds; LAS int* scan = hist + 256; LAS int* misc = scan + 256;
    const float* pr = F.probs + (size_t)g * SEQ + tid * 8;
    const u32x4 p0 = *(const u32x4*)pr, p1 = *(const u32x4*)(pr + 4);
    const unsigned u[8] = {p0.x, p0.y, p0.z, p0.w, p1.x, p1.y, p1.z, p1.w};
    unsigned prefix = 0; int need = CAP;
    for (int pass = 0; pass < 4; ++pass) {
        const int shift = 24 - 8 * pass;
        __syncthreads();
        if (tid < 256) hist[tid] = 0;
        __syncthreads();
#pragma unroll
        for (int j = 0; j < 8; ++j) { const bool match = (pass == 0) || ((u[j] >> (shift + 8)) == prefix);
            if (match) __hip_atomic_fetch_add(hist + ((u[j] >> shift) & 255u), 1, __ATOMIC_RELAXED, __HIP_MEMORY_SCOPE_WORKGROUP); }
        __syncthreads();
        if (tid < 256) scan[tid] = hist[tid];
        __syncthreads();
        for (int off = 1; off < 256; off <<= 1) { int val = 0; if (tid < 256) { val = scan[tid]; if (tid + off < 256) val += scan[tid + off]; }
            __syncthreads(); if (tid < 256) scan[tid] = val; __syncthreads(); }
        if (tid < 256) { const int incl = scan[tid], above = (tid < 255) ? scan[tid + 1] : 0; if (incl >= need && above < need) { misc[0] = tid; misc[1] = above; } }
        __syncthreads();
        prefix = (prefix << 8) | (unsigned)misc[0]; need -= misc[1];
    }
    const unsigned T = prefix;
    int cg = 0, ce = 0;
#pragma unroll
    for (int j = 0; j < 8; ++j) { cg += (u[j] > T); ce += (u[j] == T); }
    int pk = cg | (ce << 16), inc = pk;
#pragma unroll
    for (int o = 1; o < 64; o <<= 1) { const int t = __shfl_up(inc, o); if (lane >= o) inc += t; }
    __syncthreads();
    if (lane == 63) misc[8 + wave] = inc;
    __syncthreads();
    int base = 0;
#pragma unroll
    for (int w = 0; w < NWAVES; ++w) if (w < wave) base += misc[8 + w];
    const int excl = base + inc - pk; int rg = excl & 0xffff, re = excl >> 16;
    const int cgt = CAP - need;
    const int b = g >> 4, e = g & 15;
#pragma unroll
    for (int j = 0; j < 8; ++j) { const int n = tid * 8 + j; int slot = -1;
        if (u[j] > T) { slot = rg; ++rg; } else if (u[j] == T) { if (re < need) slot = cgt + re; ++re; }
        if (slot >= 0) { F.idx[g * CAP + slot] = n; F.gate[g * CAP + slot] = __uint_as_float(u[j]); }
        F.sel[((size_t)(b * SEQ + n)) * NE + e] = slot; }
}

DI void p10_final(Frame& F) {
    const Args& A = F.a; const int gw = F.blk * NWAVES + F.wave, ngw = F.nblk * NWAVES, lane = F.lane;
    for (int tok = gw; tok < MTOK; tok += ngw) {
        const int b = tok >> 12; const float* md = F.mod + (size_t)b * MODW + 5 * DM;
        const int sv = (lane < NE) ? F.sel[(size_t)tok * NE + lane] : -1;
        float y[16];
#pragma unroll
        for (int j = 0; j < 16; ++j) y[j] = 0.f;
#pragma unroll
        for (int e = 0; e < NE; ++e) { const int s = __builtin_amdgcn_readlane(sv, e);
            if (s >= 0) { const bf16_t* row = F.mout + ((size_t)(b * NE + e) * CAP + s) * DM;
                const u32x4 w0 = *(const u32x4*)(row + 8 * lane), w1 = *(const u32x4*)(row + 512 + 8 * lane);
                y[0] += bflo(w0.x); y[1] += bfhi(w0.x); y[2] += bflo(w0.y); y[3] += bfhi(w0.y); y[4] += bflo(w0.z); y[5] += bfhi(w0.z); y[6] += bflo(w0.w); y[7] += bfhi(w0.w);
                y[8] += bflo(w1.x); y[9] += bfhi(w1.x); y[10] += bflo(w1.y); y[11] += bfhi(w1.y); y[12] += bflo(w1.z); y[13] += bfhi(w1.z); y[14] += bflo(w1.w); y[15] += bfhi(w1.w); } }
        float* xr = A.out + (size_t)tok * DM; float xf[16]; float ss = 0.f;
#pragma unroll
        for (int hlf = 0; hlf < 2; ++hlf)
#pragma unroll
            for (int q = 0; q < 2; ++q) { const int col = hlf * 512 + 8 * lane + 4 * q; const f32x4 xv = *(const f32x4*)(xr + col), g2 = *(const f32x4*)(md + col);
#pragma unroll
                for (int j = 0; j < 4; ++j) { const float t = xv[j] + g2[j] * y[hlf * 8 + q * 4 + j]; xf[hlf * 8 + q * 4 + j] = t; ss += t * t; } }
        const float rstd = rsqrtf(wave_sum(ss) * (1.0f / DM) + EPS);
#pragma unroll
        for (int hlf = 0; hlf < 2; ++hlf)
#pragma unroll
            for (int q = 0; q < 2; ++q) { const int col = hlf * 512 + 8 * lane + 4 * q; const f32x4 fg = *(const f32x4*)(A.final_g + col); f32x4 o;
#pragma unroll
                for (int j = 0; j < 4; ++j) o[j] = xf[hlf * 8 + q * 4 + j] * rstd * fg[j];
                *(f32x4*)(xr + col) = o; }
    }
}

constexpr int NPHASE = 11;
__global__ void __launch_bounds__(NTHR, 2) hymba_fwd(Args args) {
    extern __shared__ __attribute__((aligned(16))) unsigned char lds_raw[];
    Frame F;
    F.lds = (LAS unsigned char*)lds_raw; F.tid = threadIdx.x; F.lane = F.tid & 63; F.wave = __builtin_amdgcn_readfirstlane(F.tid >> 6);
    F.blk = blockIdx.x; F.nblk = gridDim.x; F.a = args;
    unsigned char* ws = args.ws;
    F.mod = (float*)(ws + WS_MOD); F.lb = (float*)(ws + WS_LB); F.probs = (float*)(ws + WS_PROBS); F.idx = (int*)(ws + WS_IDX); F.gate = (float*)(ws + WS_GATE); F.sel = (int*)(ws + WS_SEL);
    F.win = (bf16_t*)(ws + WS_WIN); F.wout = (bf16_t*)(ws + WS_WOUT); F.wgu = (bf16_t*)(ws + WS_WGU); F.wdn = (bf16_t*)(ws + WS_WDN);
    F.h = (bf16_t*)(ws + WS_H); F.mixed = (bf16_t*)(ws + WS_H); F.h2 = (bf16_t*)(ws + WS_H2); F.cpre = (bf16_t*)(ws + WS_CPRE); F.of = (bf16_t*)(ws + WS_OF); F.ob = (bf16_t*)(ws + WS_OB);
    F.proj = (bf16_t*)(ws + WS_PROJ); F.pctx = (bf16_t*)(ws + WS_PCTX); F.hid = (bf16_t*)(ws + WS_PROJ); F.mout = (bf16_t*)(ws + WS_MOUT);
    const int lo = args.ph_lo, hi = args.ph_hi;
#define IN(k) (lo <= (k) && (k) < hi)
    if (IN(0)) p0_prologue(F);
    if (IN(1)) p1_rows(F);
    if (IN(2)) {
        { ProbDense P; P.A = F.h; P.Bt = F.win; P.K = DM; P.ord.init(MTOK / 256, INC / 256, F.nblk, F.blk);
          EpiBf16 E{F.proj, INC}; pg8::gemm_phase<ProbDense, EpiBf16, true, true>(F.lds, P, E); }
        { ProbDense P; P.A = F.h + (size_t)MTOK * DM; P.Bt = F.win + (size_t)OFF_I * DM; P.K = DM; P.ord.init(MCTX / 256, PCW / 256, F.nblk, F.blk);
          EpiBf16 E{F.pctx, PCW}; pg8::gemm_phase<ProbDense, EpiBf16, true, true>(F.lds, P, E); }
    }
    if (IN(3)) {
        const int nscan = NB * NH * 2;
        if (F.nblk >= 2 * nscan) {
            if (F.blk < nscan) scan_naive_item(F, F.blk);
            else { const int cb = F.blk - nscan, ncb = F.nblk - nscan; for (int it = cb * NWAVES + F.wave; it < 4096; it += ncb * NWAVES) conv_item(F, it); }
        } else {
            for (int it = F.blk; it < nscan; it += F.nblk) scan_naive_item(F, it);
            for (int it = F.blk * NWAVES + F.wave; it < 4096; it += F.nblk * NWAVES) conv_item(F, it);
        }
    }
    if (IN(4)) p4_mixed(F);
    if (IN(5)) { ProbDense P; P.A = F.mixed; P.Bt = F.wout; P.K = DM; P.ord.init(MTOK / 256, DM / 256, F.nblk, F.blk);
        EpiX1 E{args.x, F.mod, args.out}; pg8::gemm_phase<ProbDense, EpiX1, true, true>(F.lds, P, E); }
    if (IN(6)) p6_rows(F);
    if (IN(7)) for (int g = F.blk; g < NGRP; g += F.nblk) topk_item(F, g);
    if (IN(8)) { ProbMoeUp P; P.A = F.h2; P.Bt = F.wgu; P.idx = F.idx; P.K = DM; P.ord.init(MROWS / 256, 2 * FF / 256, F.nblk, F.blk);
        EpiSwiglu E{F.hid}; pg8::gemm_phase<ProbMoeUp, EpiSwiglu, true, true>(F.lds, P, E); }
    if (IN(9)) { ProbMoeDown P; P.A = F.hid; P.Bt = F.wdn; P.K = FF; P.ord.init(MROWS / 256, DM / 256, F.nblk, F.blk);
        EpiDown E{F.mout, F.gate}; pg8::gemm_phase<ProbMoeDown, EpiDown, true, true>(F.lds, P, E); }
    if (IN(10)) p10_final(F);
#undef IN
}

extern "C" void kernel_launch(void* const* d_in, const int* in_sizes, int n_in, void* d_out, int out_size, void* d_ws, size_t ws_size, hipStream_t stream) {
    static int grid = 0;
    if (grid == 0) {
        if (n_in != 21 || in_sizes[0] != MTOK * DM || out_size != MTOK * DM || ws_size < WS_END) { fprintf(stderr, "kernel_launch: unexpected shapes (n_in %d, in0 %d, out %d, ws %zu)\n", n_in, n_in > 0 ? in_sizes[0] : -1, out_size, ws_size); grid = -1; return; }
        int dev = 0, cus = 0, per_cu = 0;
        if (hipGetDevice(&dev) != hipSuccess || hipDeviceGetAttribute(&cus, hipDeviceAttributeMultiprocessorCount, dev) != hipSuccess) { grid = -1; return; }
        if (hipFuncSetAttribute((const void*)hymba_fwd, hipFuncAttributeMaxDynamicSharedMemorySize, LDS_BYTES) != hipSuccess) { fprintf(stderr, "kernel_launch: hipFuncSetAttribute failed\n"); grid = -1; return; }
        if (hipOccupancyMaxActiveBlocksPerMultiprocessor(&per_cu, (const void*)hymba_fwd, NTHR, LDS_BYTES) != hipSuccess || per_cu < 1) { fprintf(stderr, "kernel_launch: occupancy query says %d\n", per_cu); per_cu = 1; }
        (void)hipGetLastError();
        grid = cus;
    }
    if (grid < 0) return;
    Args a{};
    const float** ap = (const float**)&a;
    for (int i = 0; i < 21; ++i) ap[i] = (const float*)d_in[i];
    a.out = (float*)d_out; a.ws = (unsigned char*)d_ws;
    for (int ph = 0; ph < NPHASE; ++ph) { a.ph_lo = ph; a.ph_hi = ph + 1; hipLaunchKernelGGL(hymba_fwd, dim3(grid), dim3(NTHR), LDS_BYTES, stream, a); }
}
```

```cpp
#include <hip/hip_runtime.h>
#include <hip/hip_cooperative_groups.h>
#include <cstdio>
namespace cg = cooperative_groups;

#ifndef BARRIER_KIND
#define BARRIER_KIND 1
#endif
#ifndef N_LANES
#define N_LANES 2
#endif

#define LAS __attribute__((address_space(3)))
#define DI __device__ __forceinline__
typedef unsigned short bf16_t;
typedef short bf16x8 __attribute__((ext_vector_type(8)));
typedef float f32x4 __attribute__((ext_vector_type(4)));
typedef float f32x2 __attribute__((ext_vector_type(2)));
typedef unsigned u32x4 __attribute__((ext_vector_type(4)));
typedef unsigned u32x2 __attribute__((ext_vector_type(2)));

constexpr int NB = 16, SEQ = 4096, DM = 1024, MTOK = NB * SEQ, CTXL = 256, MCTX = NB * CTXL;
constexpr int GW = 64;
constexpr int CWID = 512, HWID = 512, HD = 128, NH = 4, CK = 31, CPAD = 15;
constexpr int NE = 16, FF = 1024, CAP = 512, NGRP = NB * NE, MROWS = NGRP * CAP;
constexpr int OFF_A = 0, OFF_B = 512, OFF_Q = 1024, OFF_I = 1536, OFF_FF = 2048, OFF_FB = 2560, OFF_G = 3072, INC = 3584;
constexpr int PCW = 1536;
constexpr int MODW = 6 * DM;
constexpr float EPS = 1e-6f;

constexpr size_t MiB = 1u << 20;
constexpr size_t WS_CTL = 0;
constexpr size_t WS_MOD = 1 * MiB;
constexpr size_t WS_LB = WS_MOD + 512 * 1024;
constexpr size_t WS_PROBS = 2 * MiB;
constexpr size_t WS_IDX = 6 * MiB;
constexpr size_t WS_GATE = 6 * MiB + 512 * 1024;
constexpr size_t WS_SEL = 7 * MiB;
constexpr size_t WS_WIN = 16 * MiB;
constexpr size_t WS_WOUT = 23 * MiB;
constexpr size_t WS_WGU = 25 * MiB;
constexpr size_t WS_WDN = 89 * MiB;
constexpr size_t WS_H = 128 * MiB;
constexpr size_t WS_PL = 264 * MiB;
constexpr size_t PLANE = 8 * MiB;
constexpr size_t HREG = 40 * PLANE;
DI size_t fix_pl(int h) { return (size_t)h * (HREG - PLANE); }
DI size_t fix_h2(int h) { return (size_t)h * (HREG - 32 * MiB); }
DI size_t fix_mix(int h) { return (size_t)h * (HREG - 64 * MiB); }
DI size_t fix_hid(int h) { return (size_t)h * (HREG - 64 * MiB); }
DI size_t fix_mout(int h) { return (size_t)h * (HREG - 128 * MiB); }
constexpr int PL_U = 0, PL_Q = 4, PL_I = 8, PL_FF = 12, PL_FB = 16, PL_G = 20, PL_QB = 24, PL_OF = 28, PL_OB = 32, PL_CPRE = 36, NPLANES = 40;
constexpr size_t WS_PCTX = 904 * MiB;
constexpr size_t CPLANE = 1 * MiB;
constexpr size_t WS_EARR = 916 * MiB;
constexpr size_t WS_H2 = WS_PL;
constexpr size_t WS_HID = WS_PL + 12 * PLANE;
constexpr size_t WS_MOUT = WS_PL + 20 * PLANE;
constexpr size_t WS_MIX = WS_PL + 4 * PLANE;
constexpr size_t WS_END = 922 * MiB;
static_assert(WS_PL + 2 * HREG <= WS_PCTX, "plane regions");
constexpr int NCHK = 4 + 64;

constexpr int LDS_BYTES = 147456, MISC_OFF = 147456 - 128;
constexpr int NTHR = 512, NWAVES = 8;

struct Args {
    const float *x, *c, *ctx, *c_ctx, *ada_w, *ada_b, *norm1_g, *w_in, *taps, *conv_bias, *ln_g, *ln_b, *lb_logits, *hgrn_g, *w_out, *norm2_g, *router, *w_gate, *w_up, *w_down, *final_g;
    float* out; unsigned char* ws; int ph_lo, ph_hi;
};

DI float bf2f(bf16_t b) { return __uint_as_float(((unsigned)b) << 16); }
DI unsigned f2bf(float f) { unsigned u = __float_as_uint(f); return (u + 0x7fffu + ((u >> 16) & 1u)) >> 16; }
DI unsigned pk2(float lo, float hi) { return f2bf(lo) | (f2bf(hi) << 16); }
DI float bflo(unsigned w) { return __uint_as_float(w << 16); }
DI float bfhi(unsigned w) { return __uint_as_float(w & 0xffff0000u); }
DI float sigmoidf_(float x) { return __builtin_amdgcn_rcpf(1.0f + __expf(-x)); }
DI float siluf_(float x) { return x * __builtin_amdgcn_rcpf(1.0f + __expf(-x)); }
DI float wave_sum(float v) {
#pragma unroll
    for (int o = 1; o < 64; o <<= 1) v += __shfl_xor(v, o);
    return v;
}
typedef float f32x2_t __attribute__((ext_vector_type(2))); typedef __bf16 bf16x2_t __attribute__((ext_vector_type(2)));
DI unsigned cvtpk_s(float lo, float hi) { f32x2_t v = {lo, hi}; bf16x2_t b = __builtin_convertvector(v, bf16x2_t); return __builtin_bit_cast(unsigned, b); }

namespace pg8 {
constexpr int BM = 256, BK = 64, HALF = 128, HTB = HALF * BK * 2, STAGE_BYTES = 8 * HTB, NXCD = 8, WGM = 8;
DI int lds_byte(int r, int c) { const int st = (r >> 4) * 2 + (c >> 5), rr = r & 15, cc = c & 31, ob = rr * 64 + cc * 2; return st * 1024 + (ob ^ (((ob >> 9) & 1) << 5)); }
DI void stage_rc(int b, int& R, int& C) { const int st = b / 1024, sb = b % 1024, swz = sb ^ (((sb >> 9) & 1) << 5); R = (st >> 1) * 16 + swz / 64; C = (st & 1) * 32 + (swz % 64) / 2; }
DI int perm32(int rho) { const int n = rho >> 4, i = rho & 15; return 8 * (i >> 2) + 4 * n + (i & 3); }
struct Unit { int pm, pn; };
typedef int v8i __attribute__((ext_vector_type(8))); typedef int v4i __attribute__((ext_vector_type(4)));
DI void mfma_fp8(f32x4& acc, const v8i& a, const v8i& b, int sc) { asm volatile("v_mfma_scale_f32_16x16x128_f8f6f4 %0, %1, %2, %0, %3, %3 op_sel_hi:[0,0,0]" : "+v"(acc) : "v"(a), "v"(b), "v"(sc)); }
DI v8i cat8(bf16x8 a, bf16x8 b) { return __builtin_shufflevector(__builtin_bit_cast(v4i, a), __builtin_bit_cast(v4i, b), 0, 1, 2, 3, 4, 5, 6, 7); }

struct TileOrder {
    int nM, nN, nwg, G, c, pm0, moe_b0, gm; bool own;
    DI void init(int nM_, int nN_, int G_, int c_, int pm0_ = 0, int moe_b0_ = -1) { nM = nM_; nN = nN_; nwg = nM * nN; G = G_; c = c_; pm0 = pm0_; moe_b0 = moe_b0_; own = false; gm = -1; }
    DI void init_own(int nM_, int nN_, int G_, int c_, int pm0_) { init(nM_, nN_, G_, c_, pm0_); own = true; }
    DI void init_group(int nN_, int gm_) { init(2, nN_, 1, 0); gm = gm_; }
    DI bool next(int i, Unit& u) const {
        if (gm >= 0) { if (i >= 2 * nN) return false; const int r = i >= nN ? 1 : 0; u.pn = i - r * nN; u.pm = gm + r; return true; }
        if (own) { const int r = i / nN, pml = c + r * G; if (pml >= nM) return false; u.pn = i - r * nN; u.pm = pml + pm0; return true; }
        const long L = (long)i * G + c; if (L >= nwg) return false;
        int wgid = (int)L; { const int q = nwg / NXCD, r = nwg % NXCD, xcd = wgid % NXCD, off = wgid / NXCD; wgid = (xcd < r ? xcd * (q + 1) : r * (q + 1) + (xcd - r) * q) + off; }
        const int nig = WGM * nN, gid = wgid / nig, fm = gid * WGM, gsz = (nM - fm) < WGM ? (nM - fm) : WGM;
        const int pml = fm + ((wgid % nig) % gsz); u.pn = (wgid % nig) / gsz;
        u.pm = moe_b0 >= 0 ? ((pml >> 4) * 32 + (moe_b0 + ((pml >> 1) & 7)) * 2 + (pml & 1)) : pml + pm0; return true;
    }
};

template <class Prob, class Epi, bool ALIGN_EPI>
DI void gemm_phase(LAS unsigned char* lds, const int tid, const Prob& P, const Epi& E) {
    constexpr bool GATHER = Prob::GATHER, FP8 = Prob::FP8;
    const int wid = __builtin_amdgcn_readfirstlane(tid >> 6), lane = tid & 63, wr = wid >> 2, wc = wid & 3, fr = lane & 15, fq = lane >> 4;
    const int KB = P.K * (FP8 ? 1 : 2), nt = KB / 128;
    unsigned voffA[2], voffB[2];
#pragma unroll
    for (int i = 0; i < 2; ++i) { int R, C; stage_rc(tid * 16 + i * 8192, R, C); const int Rb = Epi::PERM ? ((R & ~31) + perm32(R & 31)) : R; voffA[i] = (unsigned)(R * KB + C * 2); voffB[i] = (unsigned)(Rb * KB + C * 2); }
    const unsigned kstep = 128u;
    const size_t hstep = (size_t)HALF * KB;
    const unsigned ldsw = (unsigned)wid * 1024u;
    const int aoff = lds_byte(wr * 64 + fr, fq * 8), boff = lds_byte(wc * 32 + fr, fq * 8);
#define PG8_SA(b, h) (((b) * 2 + (h)) * HTB)
#define PG8_SB(b, h) ((4 + (b) * 2 + (h)) * HTB)
#define PG8_STAGE(bufoff, gbase, voff) do { _Pragma("unroll") for (int _i = 0; _i < 2; ++_i) \
        __builtin_amdgcn_global_load_lds((const unsigned*)((const char*)(gbase) + (voff)[_i]), (LAS unsigned*)(lds + (bufoff) + ldsw + _i * 8192), 16, 0, 0); } while (0)
#define PG8_LDA(dst, b, h) do { _Pragma("unroll") for (int m = 0; m < 4; ++m) { if constexpr (FP8) { dst##8[m] = cat8(*(const LAS bf16x8*)(lds + PG8_SA(b, h) + aoff + m * 2048), *(const LAS bf16x8*)(lds + PG8_SA(b, h) + aoff + m * 2048 + 1024)); } \
        else { _Pragma("unroll") for (int k = 0; k < 2; ++k) dst[m][k] = *(const LAS bf16x8*)(lds + PG8_SA(b, h) + aoff + m * 2048 + k * 1024); } } } while (0)
#define PG8_LDB(dst, b, h) do { _Pragma("unroll") for (int n = 0; n < 2; ++n) { if constexpr (FP8) { dst##8[n] = cat8(*(const LAS bf16x8*)(lds + PG8_SB(b, h) + boff + n * 2048), *(const LAS bf16x8*)(lds + PG8_SB(b, h) + boff + n * 2048 + 1024)); } \
        else { _Pragma("unroll") for (int k = 0; k < 2; ++k) dst[n][k] = *(const LAS bf16x8*)(lds + PG8_SB(b, h) + boff + n * 2048 + k * 1024); } } } while (0)
#define PG8_MMA(ai, bj, At, Bt) do { if constexpr (!FP8) __builtin_amdgcn_s_setprio(1); else asm volatile("s_setprio 1"); _Pragma("unroll") for (int m = 0; m < 4; ++m) _Pragma("unroll") for (int n = 0; n < 2; ++n) { \
        if constexpr (FP8) { mfma_fp8(acc[ai][bj][m][n], Bt##8[n], At##8[m], sc1); } \
        else { _Pragma("unroll") for (int k = 0; k < 2; ++k) acc[ai][bj][m][n] = __builtin_amdgcn_mfma_f32_16x16x32_bf16(Bt[n][k], At[m][k], acc[ai][bj][m][n], 0, 0, 0); } } \
        if constexpr (!FP8) __builtin_amdgcn_s_setprio(0); else asm volatile("s_setprio 0"); } while (0)
#define PG8_WAIT_V(n) asm volatile("s_waitcnt vmcnt(" #n ")" ::: "memory")
#define PG8_WAIT_L(n) asm volatile("s_waitcnt lgkmcnt(" #n ")" ::: "memory")
#define PG8_BAR __builtin_amdgcn_s_barrier()
#define PG8_SCHED __builtin_amdgcn_sched_barrier(0)
#define PG8_STA(buf, base, V, h) do { if constexpr (GATHER) { PG8_STAGE_G(buf, base, V, h); } else { PG8_STAGE(buf, base, V); } } while (0)
#define PG8_KBODY(A1, VA1, A2H0, V2, A2H1, A3H0, B2, B3) do { \
            PG8_LDB(B0, 0, 0); PG8_LDB(B1, 0, 1); PG8_SCHED; PG8_LDA(At, 0, 0); PG8_STA(PG8_SA(1, 1), A1, VA1, 1); \
            PG8_WAIT_V(8); PG8_WAIT_L(0); PG8_BAR; PG8_MMA(0, 0, At, B0); PG8_MMA(0, 1, At, B1); PG8_BAR; PG8_SCHED; \
            PG8_LDA(At, 0, 1); PG8_STAGE(PG8_SB(0, 0), B2, voffB); PG8_STAGE(PG8_SB(0, 1), (B2) + hstep, voffB); PG8_STA(PG8_SA(0, 0), A2H0, V2, 0); \
            PG8_WAIT_V(8); PG8_WAIT_L(0); PG8_BAR; PG8_MMA(1, 0, At, B0); PG8_MMA(1, 1, At, B1); PG8_BAR; PG8_SCHED; \
            PG8_LDB(B0, 1, 0); PG8_LDB(B1, 1, 1); PG8_SCHED; PG8_LDA(At, 1, 0); PG8_STA(PG8_SA(0, 1), A2H1, V2, 1); \
            PG8_WAIT_V(8); PG8_WAIT_L(0); PG8_BAR; PG8_MMA(0, 0, At, B0); PG8_MMA(0, 1, At, B1); PG8_BAR; PG8_SCHED; \
            PG8_LDA(At, 1, 1); PG8_STAGE(PG8_SB(1, 0), B3, voffB); PG8_STAGE(PG8_SB(1, 1), (B3) + hstep, voffB); PG8_STA(PG8_SA(1, 0), A3H0, V2, 0); \
            PG8_WAIT_V(8); PG8_WAIT_L(0); PG8_BAR; PG8_MMA(1, 0, At, B0); PG8_MMA(1, 1, At, B1); PG8_BAR; PG8_SCHED; } while (0)
    Unit cur, nxt; int ui = 0;
    if (!P.next(0, cur)) return;
    f32x4 acc[2][2][4][2];
#pragma unroll
    for (int a = 0; a < 2; ++a)
#pragma unroll
        for (int b = 0; b < 2; ++b)
#pragma unroll
            for (int m = 0; m < 4; ++m)
#pragma unroll
                for (int n = 0; n < 2; ++n) acc[a][b][m][n] = (f32x4){0.f, 0.f, 0.f, 0.f};
    int sc1 = 0x7f7f7f7f; asm volatile("" : "+v"(sc1));
    bf16x8 At[4][2], B0[2][2], B1[2][2]; v8i At8[4], B08[2], B18[2];
    unsigned pa[2], c2[2];
    const char* cA;
    if constexpr (GATHER) { P.a_rows(cur, tid, pa); cA = (const char*)P.a_base(cur);
#pragma unroll
        for (int i = 0; i < 2; ++i) { int R, C; stage_rc(tid * 16 + i * 8192, R, C); c2[i] = (unsigned)(C * 2); } }
    else { cA = (const char*)P.a_tile(cur); }
#define PG8_STAGE_G(bufoff, gbase, pk, h) do { _Pragma("unroll") for (int _i = 0; _i < 2; ++_i) { const unsigned _off = (((pk)[_i] >> (16 * (h))) & 0xffffu) * (unsigned)KB + c2[_i]; \
        __builtin_amdgcn_global_load_lds((const unsigned*)((const char*)(gbase) + _off), (LAS unsigned*)(lds + (bufoff) + ldsw + _i * 8192), 16, 0, 0); } } while (0)
    const char* cB = (const char*)P.b_base(cur);
    PG8_STAGE(PG8_SB(0, 0), cB, voffB); PG8_STAGE(PG8_SB(0, 1), cB + hstep, voffB);
    if constexpr (GATHER) { PG8_STAGE_G(PG8_SA(0, 0), cA, pa, 0); PG8_STAGE_G(PG8_SA(0, 1), cA, pa, 1); } else { PG8_STAGE(PG8_SA(0, 0), cA, voffA); PG8_STAGE(PG8_SA(0, 1), cA + hstep, voffA); }
    if (wr == 1) PG8_BAR;
    PG8_WAIT_V(2); PG8_BAR;
    PG8_STAGE(PG8_SB(1, 0), cB + kstep, voffB);
    if constexpr (GATHER) { PG8_STAGE_G(PG8_SA(1, 0), cA + kstep, pa, 0); } else { PG8_STAGE(PG8_SA(1, 0), cA + kstep, voffA); }
    PG8_STAGE(PG8_SB(1, 1), cB + hstep + kstep, voffB);
    PG8_WAIT_V(6); PG8_BAR;
    for (;;) {
        const bool has_next = P.next(ui + 1, nxt);
        const char* nB = has_next ? (const char*)P.b_base(nxt) : cB;
        if constexpr (GATHER) {
            unsigned pn[2]; const char* nA = has_next ? (const char*)P.a_base(nxt) : cA;
            if (has_next) P.a_rows(nxt, tid, pn); else { pn[0] = pa[0]; pn[1] = pa[1]; }
            for (int t = 0; t < nt; t += 2) {
                const bool last = (t == nt - 2);
                const char* a1 = cA + (size_t)(t + 1) * kstep;
                const char* a2 = last ? nA : cA + (size_t)(t + 2) * kstep; const char* b2 = last ? nB : cB + (size_t)(t + 2) * kstep;
                unsigned p2[2]; p2[0] = last ? pn[0] : pa[0]; p2[1] = last ? pn[1] : pa[1];
                PG8_KBODY(a1, pa, a2, p2, a2, a2 + kstep, b2, b2 + kstep); }
            pa[0] = pn[0]; pa[1] = pn[1]; cA = nA;
        } else {
            const char* nA = has_next ? (const char*)P.a_tile(nxt) : cA;
            for (int t = 0; t < nt; t += 2) {
                const bool last = (t == nt - 2);
                const char* a1 = cA + hstep + (size_t)(t + 1) * kstep;
                const char* a2 = last ? nA : cA + (size_t)(t + 2) * kstep; const char* b2 = last ? nB : cB + (size_t)(t + 2) * kstep;
                PG8_KBODY(a1, voffA, a2, voffA, a2 + hstep, a2 + kstep, b2, b2 + kstep); }
            cA = nA;
        }
        if constexpr (ALIGN_EPI) { if (wr == 0) PG8_BAR; }
        if constexpr (FP8) asm volatile("s_nop 15\n\ts_nop 15" ::: "memory");
        E(acc, cur, wr, wc, fr, fq);
        if (!has_next) break;
#pragma unroll
        for (int a = 0; a < 2; ++a)
#pragma unroll
            for (int b = 0; b < 2; ++b)
#pragma unroll
                for (int m = 0; m < 4; ++m)
#pragma unroll
                    for (int n = 0; n < 2; ++n) acc[a][b][m][n] = (f32x4){0.f, 0.f, 0.f, 0.f};
        cur = nxt; cB = nB; ++ui;
        if constexpr (ALIGN_EPI) { if (wr == 1) PG8_BAR; }
    }
    PG8_WAIT_V(0);
    if constexpr (!ALIGN_EPI) { if (wr == 0) PG8_BAR; }
    PG8_BAR;
#undef PG8_KBODY
#undef PG8_STA
#undef PG8_STAGE_G
#undef PG8_SA
#undef PG8_SB
#undef PG8_STAGE
#undef PG8_LDA
#undef PG8_LDB
#undef PG8_MMA
#undef PG8_WAIT_V
#undef PG8_WAIT_L
#undef PG8_BAR
#undef PG8_SCHED
}
}
using pg8::Unit;

struct ProbDense {
    static constexpr bool GATHER = false, FP8 = false;
    const bf16_t* A; const bf16_t* Bt; int K; pg8::TileOrder ord;
    DI bool next(int i, Unit& u) const { return ord.next(i, u); }
    DI const void* a_tile(const Unit& u) const { return A + (size_t)u.pm * 256 * K; }
    DI const void* b_base(const Unit& u) const { return Bt + (size_t)u.pn * 256 * K; }
};
DI void moe_unit(int pmv, int& g, int& half, int& e) { e = pmv >> 5; const int b = (pmv >> 1) & 15; half = pmv & 1; g = b * NE + e; }
struct ProbMoeUp {
    static constexpr bool GATHER = true, FP8 = true;
    const unsigned char* A; const unsigned char* Bt; const int* idx; int K; pg8::TileOrder ord;
    DI bool next(int i, Unit& u) const { return ord.next(i, u); }
    DI const void* a_base(const Unit& u) const { return A + fix_h2(((u.pm >> 1) & 15) >> 3); }
    DI const void* b_base(const Unit& u) const { int g, half, e; moe_unit(u.pm, g, half, e); return Bt + ((size_t)e * 2048 + (size_t)u.pn * 256) * K; }
    DI void a_rows(const Unit& u, int tid, unsigned (&pk)[2]) const {
        int g, half, e; moe_unit(u.pm, g, half, e); const int b = g >> 4;
#pragma unroll
        for (int i = 0; i < 2; ++i) { int R, C; pg8::stage_rc(tid * 16 + i * 8192, R, C);
            const int t0 = idx[g * CAP + half * 256 + R], t1 = idx[g * CAP + half * 256 + 128 + R]; pk[i] = (unsigned)(b * SEQ + t0) | ((unsigned)(b * SEQ + t1) << 16); }
    }
};
struct ProbMoeDown {
    static constexpr bool GATHER = false, FP8 = true;
    const unsigned char* A; const unsigned char* Bt; int K; pg8::TileOrder ord;
    DI bool next(int i, Unit& u) const { return ord.next(i, u); }
    DI const void* a_tile(const Unit& u) const { int g, half, e; moe_unit(u.pm, g, half, e); return A + fix_hid(g >> 7) + ((size_t)g * CAP + half * 256) * K; }
    DI const void* b_base(const Unit& u) const { int g, half, e; moe_unit(u.pm, g, half, e); return Bt + ((size_t)e * 1024 + (size_t)u.pn * 256) * K; }
};

DI void store8(bf16_t* p, const f32x4 v0, const f32x4 v1) { u32x4 w; w.x = cvtpk_s(v0[0], v0[1]); w.y = cvtpk_s(v0[2], v0[3]); w.z = cvtpk_s(v1[0], v1[1]); w.w = cvtpk_s(v1[2], v1[3]); *(u32x4*)p = w; }
struct EpiPlanes {
    static constexpr bool PERM = true;
    bf16_t* pl0;
    DI void operator()(const f32x4 (&acc)[2][2][4][2], const Unit& u, int wr, int wc, int fr, int fq) const {
        const int row0 = u.pm * 256 + wr * 64 + fr, col0 = wc * 32 + 8 * fq;
        bf16_t* const pl = pl0 + fix_pl(u.pm >> 7) / 2;
        if (u.pn < 4) {
            bf16_t* base = pl + (size_t)u.pn * (PLANE / 2) + col0;
#pragma unroll
            for (int ai = 0; ai < 2; ++ai)
#pragma unroll
                for (int m = 0; m < 4; ++m) { f32x4 r0, r1;
#pragma unroll
                    for (int j = 0; j < 4; ++j) { r0[j] = acc[ai][0][m][0][j] * sigmoidf_(acc[ai][1][m][0][j]); r1[j] = acc[ai][0][m][1][j] * sigmoidf_(acc[ai][1][m][1][j]); }
                    store8(base + (size_t)(row0 + ai * 128 + m * 16) * 128, r0, r1); }
        } else {
            bf16_t* base = pl + (size_t)(2 * u.pn - 4) * (PLANE / 2) + col0;
#pragma unroll
            for (int ai = 0; ai < 2; ++ai)
#pragma unroll
                for (int m = 0; m < 4; ++m)
#pragma unroll
                    for (int bj = 0; bj < 2; ++bj) store8(base + (size_t)bj * (PLANE / 2) + (size_t)(row0 + ai * 128 + m * 16) * 128, acc[ai][bj][m][0], acc[ai][bj][m][1]);
        }
    }
};
struct EpiCtxPlanes {
    static constexpr bool PERM = true;
    bf16_t* pl;
    DI void operator()(const f32x4 (&acc)[2][2][4][2], const Unit& u, int wr, int wc, int fr, int fq) const {
        const int row0 = u.pm * 256 + wr * 64 + fr, col0 = wc * 32 + 8 * fq;
        bf16_t* base = pl + (size_t)(2 * u.pn) * (CPLANE / 2) + col0;
#pragma unroll
        for (int ai = 0; ai < 2; ++ai)
#pragma unroll
            for (int m = 0; m < 4; ++m)
#pragma unroll
                for (int bj = 0; bj < 2; ++bj) store8(base + (size_t)bj * (CPLANE / 2) + (size_t)(row0 + ai * 128 + m * 16) * 128, acc[ai][bj][m][0], acc[ai][bj][m][1]);
    }
};
struct EpiX1 {
    static constexpr bool PERM = true;
    bf16_t* O; const float* x; const float* mod;
    DI void operator()(const f32x4 (&acc)[2][2][4][2], const Unit& u, int wr, int wc, int fr, int fq) const {
        const int row0 = u.pm * 256 + wr * 64 + fr, col0 = u.pn * 256 + wc * 64 + 8 * fq;
        bf16_t* const Oh = O + fix_mix(u.pm >> 7) / 2;
        const float* const g1p = mod + (size_t)(u.pm >> 4) * MODW + 2 * DM + col0;
        f32x4 g1[2][2];
#pragma unroll
        for (int bj = 0; bj < 2; ++bj) { g1[bj][0] = *(const f32x4*)(g1p + bj * 32); g1[bj][1] = *(const f32x4*)(g1p + bj * 32 + 4); }
#pragma unroll
        for (int ai = 0; ai < 2; ++ai) {
            f32x4 xv[4][2][2];
#pragma unroll
            for (int m = 0; m < 4; ++m)
#pragma unroll
                for (int bj = 0; bj < 2; ++bj) { const float* xp = x + (size_t)(row0 + ai * 128 + m * 16) * DM + col0 + bj * 32; xv[m][bj][0] = *(const f32x4*)xp; xv[m][bj][1] = *(const f32x4*)(xp + 4); }
#pragma unroll
            for (int m = 0; m < 4; ++m)
#pragma unroll
                for (int bj = 0; bj < 2; ++bj) store8(Oh + (size_t)(row0 + ai * 128 + m * 16) * DM + col0 + bj * 32, xv[m][bj][0] + g1[bj][0] * acc[ai][bj][m][0], xv[m][bj][1] + g1[bj][1] * acc[ai][bj][m][1]);
        }
    }
};
constexpr float WSCALE = 32.0f, WINV = 1.0f / 32.0f;
DI unsigned pk4_fp8(float a, float b, float c, float d) { unsigned w = 0; w = __builtin_amdgcn_cvt_pk_fp8_f32(a, b, w, false); w = __builtin_amdgcn_cvt_pk_fp8_f32(c, d, w, true); return w; }
struct EpiSwiglu {
    static constexpr bool PERM = true;
    unsigned char* hid;
    DI void operator()(const f32x4 (&acc)[2][2][4][2], const Unit& u, int wr, int wc, int fr, int fq) const {
        int g, half, e; moe_unit(u.pm, g, half, e);
        const int row0 = g * CAP + half * 256 + wr * 64 + fr, col0 = u.pn * 128 + wc * 32 + 8 * fq;
#pragma unroll
        for (int ai = 0; ai < 2; ++ai)
#pragma unroll
            for (int m = 0; m < 4; ++m) { unsigned char* rowp = hid + fix_hid(g >> 7) + (size_t)(row0 + ai * 128 + m * 16) * FF + col0;
                float r[8];
#pragma unroll
                for (int n = 0; n < 2; ++n)
#pragma unroll
                    for (int j = 0; j < 4; ++j) { const float gt = acc[ai][0][m][n][j] * WINV, up = acc[ai][1][m][n][j] * WINV; r[n * 4 + j] = siluf_(gt) * up; }
                u32x2 w; w.x = pk4_fp8(r[0], r[1], r[2], r[3]); w.y = pk4_fp8(r[4], r[5], r[6], r[7]);
                *(u32x2*)rowp = w; }
    }
};
struct EpiDown {
    static constexpr bool PERM = true;
    bf16_t* O;
    DI void operator()(const f32x4 (&acc)[2][2][4][2], const Unit& u, int wr, int wc, int fr, int fq) const {
        int g, half, e; moe_unit(u.pm, g, half, e);
        const int row0 = g * CAP + half * 256 + wr * 64 + fr, col0 = u.pn * 256 + wc * 64 + 8 * fq;
#pragma unroll
        for (int ai = 0; ai < 2; ++ai)
#pragma unroll
            for (int m = 0; m < 4; ++m) { bf16_t* rowp = O + fix_mout(g >> 7) / 2 + (size_t)(row0 + ai * 128 + m * 16) * DM + col0;
#pragma unroll
                for (int bj = 0; bj < 2; ++bj) store8(rowp + bj * 32, acc[ai][bj][m][0] * WINV, acc[ai][bj][m][1] * WINV); }
    }
};

#define XB_TMO      128
#define XB_XCNT(j)  (256  + 64 * (j))
#define XB_XSUB(j)  (1280 + 64 * (j))
#define XB_XGEN(j)  (2304 + 64 * (j))
#define XB_TOP      3328
#define XB_TOPGEN   3392
#define XCD_BAR_WORDS 3456
#define XB_SPIN_CAP (1u << 18)
DI unsigned xb_ld(unsigned* p)              { return __hip_atomic_load(p, __ATOMIC_RELAXED, __HIP_MEMORY_SCOPE_AGENT); }
DI unsigned xb_add(unsigned* p, unsigned v) { return __hip_atomic_fetch_add(p, v, __ATOMIC_RELAXED, __HIP_MEMORY_SCOPE_AGENT); }
DI unsigned xb_xcc_id() { return (unsigned)__builtin_amdgcn_s_getreg((3 << 11) | 20) & 0xFu; }
#define XB_SPIN(cond, bar) do { unsigned _sp = 0; while (cond) { __builtin_amdgcn_s_sleep(1); \
    if ((++_sp & 255u) == 0u) { if (xb_ld(&(bar)[XB_TMO])) break; if (_sp > XB_SPIN_CAP) { atomicAdd(&(bar)[XB_TMO], 1u); break; } } } } while (0)
struct XcdBarrier { unsigned* bar; unsigned x; volatile LAS unsigned* st; unsigned nwg; };
DI XcdBarrier xcd_barrier_post(unsigned* bar, volatile LAS unsigned* st, bool leader, unsigned nwg) {
    XcdBarrier b; b.bar = bar; b.x = xb_xcc_id(); b.st = st; b.nwg = nwg;
    if (leader) (void)xb_add(&bar[XB_XCNT(b.x)], 1u);
    return b;
}
DI void xcd_barrier_complete(unsigned* bar, unsigned x, unsigned& nloc, unsigned& nx, const unsigned G) {
    unsigned sum, cnt, mine, sp = 0u;
    for (;;) {
        sum = 0u; cnt = 0u; mine = 0u;
#pragma unroll
        for (unsigned j = 0; j < 16; ++j) { const unsigned c = xb_ld(&bar[XB_XCNT(j)]); sum += c; cnt += (c > 0u) ? 1u : 0u; mine = (j == x) ? c : mine; }
        if (sum == G) break;
        __builtin_amdgcn_s_sleep(1);
        if ((++sp & 255u) == 0u) { if (xb_ld(&bar[XB_TMO])) break; if (sp > XB_SPIN_CAP) { atomicAdd(&bar[XB_TMO], 1u); break; } }
    }
    nloc = mine > 0u ? mine : 1u; nx = cnt > 0u ? cnt : 1u;
}
DI void xcd_barrier(const XcdBarrier& b, bool leader) {
    asm volatile("s_waitcnt vmcnt(0)" ::: "memory");
    __syncthreads();
    if (leader) {
        unsigned* bar = b.bar;
        __builtin_amdgcn_s_waitcnt(0);
        unsigned nloc = b.st[0], nx = b.st[1];
        if (nloc == 0u) { xcd_barrier_complete(bar, b.x, nloc, nx, b.nwg); b.st[0] = nloc; b.st[1] = nx; }
        const unsigned old = xb_add(&bar[XB_XSUB(b.x)], 1u);
        const unsigned gen = old / nloc;
        if (old + 1u == (gen + 1u) * nloc) {
            __builtin_amdgcn_fence(__ATOMIC_RELEASE, "agent");
            asm volatile("s_waitcnt vmcnt(0)" ::: "memory");
            const unsigned og = xb_add(&bar[XB_TOP], 1u);
            const unsigned tg = og / nx;
            if (og + 1u == (tg + 1u) * nx) xb_add(&bar[XB_TOPGEN], 1u);
            else XB_SPIN(xb_ld(&bar[XB_TOPGEN]) == tg, bar);
            __builtin_amdgcn_fence(__ATOMIC_ACQUIRE, "agent");
            xb_add(&bar[XB_XGEN(b.x)], 1u);
            asm volatile("s_waitcnt vmcnt(0)" ::: "memory");
        } else {
            XB_SPIN(xb_ld(&bar[XB_XGEN(b.x)]) == gen, bar);
            __builtin_amdgcn_fence(__ATOMIC_ACQUIRE, "agent");
            asm volatile("s_waitcnt vmcnt(0)" ::: "memory");
        }
    }
    __syncthreads();
}

struct Frame { LAS unsigned char* lds; int tid, lane, wave, blk, nblk, b0, nb; };
DI void frame_refresh(Frame& F) { int l; asm volatile("v_mbcnt_lo_u32_b32 %0, -1, 0\n\tv_mbcnt_hi_u32_b32 %0, -1, %0" : "=v"(l)); F.lane = l; F.tid = F.wave * 64 + l; }
typedef const Args __attribute__((address_space(4))) KArgs;
DI KArgs* kargs_fresh() { KArgs* p = (KArgs*)__builtin_amdgcn_kernarg_segment_ptr(); asm volatile("" : "+s"(p)); return p; }
#define WSP(T, A, off) ((T*)((A)->ws + (off)))

DI void transpose_item(const float* W, int K, int N, bf16_t* WT, int k0, int n0, int drow0, LAS float* scr, int lane) {
#pragma unroll
    for (int i = 0; i < 32; ++i) { const int kk = 2 * i + (lane >> 5); scr[kk * 33 + (lane & 31)] = W[(size_t)(k0 + kk) * N + n0 + (lane & 31)]; }
    asm volatile("s_waitcnt lgkmcnt(0)" ::: "memory");
    const int c = lane & 7;
#pragma unroll
    for (int j = 0; j < 4; ++j) { const int n = (lane >> 3) + 8 * j; const LAS float* s = scr + (8 * c) * 33 + n;
        u32x4 o; o.x = pk2(s[0 * 33], s[1 * 33]); o.y = pk2(s[2 * 33], s[3 * 33]); o.z = pk2(s[4 * 33], s[5 * 33]); o.w = pk2(s[6 * 33], s[7 * 33]);
        *(u32x4*)(WT + (size_t)(drow0 + n) * K + k0 + 8 * c) = o; }
    asm volatile("s_waitcnt lgkmcnt(0)" ::: "memory");
}
DI void transpose_item_fp8(const float* W, int K, int N, unsigned char* WT, int k0, int n0, int drow0, LAS float* scr, int lane) {
#pragma unroll
    for (int i = 0; i < 32; ++i) { const int kk = 2 * i + (lane >> 5); scr[kk * 33 + (lane & 31)] = W[(size_t)(k0 + kk) * N + n0 + (lane & 31)]; }
    asm volatile("s_waitcnt lgkmcnt(0)" ::: "memory");
    const int c = lane & 7;
#pragma unroll
    for (int j = 0; j < 4; ++j) { const int n = (lane >> 3) + 8 * j; const LAS float* s = scr + (8 * c) * 33 + n;
        u32x2 o; o.x = pk4_fp8(s[0 * 33] * WSCALE, s[1 * 33] * WSCALE, s[2 * 33] * WSCALE, s[3 * 33] * WSCALE); o.y = pk4_fp8(s[4 * 33] * WSCALE, s[5 * 33] * WSCALE, s[6 * 33] * WSCALE, s[7 * 33] * WSCALE);
        *(u32x2*)(WT + (size_t)(drow0 + n) * K + k0 + 8 * c) = o; }
    asm volatile("s_waitcnt lgkmcnt(0)" ::: "memory");
}
template <int PART>
DI void p0_transposes(Frame& F) {
    KArgs* Ap = kargs_fresh(); KArgs& A = *Ap;
    bf16_t* const win = WSP(bf16_t, Ap, WS_WIN); bf16_t* const wout = WSP(bf16_t, Ap, WS_WOUT); unsigned char* const wgu = WSP(unsigned char, Ap, WS_WGU); unsigned char* const wdn = WSP(unsigned char, Ap, WS_WDN);
    LAS float* scr = (LAS float*)(F.lds + F.wave * 16384);
    const int gw = F.blk * NWAVES + F.wave, ngw = F.nblk * NWAVES;
    constexpr int I_IN = 16 * (INC / 32), I_OUT = 16 * 32, I_E = 16 * 32;
    if constexpr (PART == 0) {
        for (int it = gw; it < I_IN + I_OUT; it += ngw) {
            int r = it;
            if (r < I_IN) { const int nb = r % (INC / 32), kb = r / (INC / 32); const int n0 = nb * 32; const int d0 = n0 < 512 ? ((n0 >> 7) * 256 + (n0 & 127)) : (n0 < 1024 ? (((n0 - 512) >> 7) * 256 + 128 + (n0 & 127)) : n0);
                transpose_item(A.w_in, DM, INC, win, kb * 64, n0, d0, scr, F.lane); continue; } r -= I_IN;
            { const int nb = r % 32, kb = r / 32, n0 = nb * 32; transpose_item(A.w_out, DM, DM, wout, kb * 64, n0, (n0 & ~255) + 128 * ((n0 >> 5) & 1) + 32 * ((n0 & 255) >> 6), scr, F.lane); }
        }
    } else {
        for (int r = gw; r < NE * 3 * I_E; r += ngw) {
            const int e = r / (3 * I_E), q = r % (3 * I_E), which = q / I_E, rr = q % I_E, nb = rr % 32, kb = rr / 32, n0 = nb * 32;
            if (which == 0) transpose_item_fp8(A.w_gate + (size_t)e * DM * FF, DM, FF, wgu + (size_t)e * 2048 * DM, kb * 64, n0, (n0 >> 7) * 256 + (n0 & 127), scr, F.lane);
            else if (which == 1) transpose_item_fp8(A.w_up + (size_t)e * DM * FF, DM, FF, wgu + (size_t)e * 2048 * DM, kb * 64, n0, (n0 >> 7) * 256 + 128 + (n0 & 127), scr, F.lane);
            else transpose_item_fp8(A.w_down + (size_t)e * FF * DM, FF, DM, wdn + (size_t)e * DM * FF, kb * 64, n0, (n0 & ~255) + 128 * ((n0 >> 5) & 1) + 32 * ((n0 & 255) >> 6), scr, F.lane);
        }
    }
}
DI void p0_prologue(Frame& F) {
    KArgs* Ap = kargs_fresh(); KArgs& A = *Ap;
    float* const mod = WSP(float, Ap, WS_MOD); float* const lbo = WSP(float, Ap, WS_LB);
    {
        LAS float* sm = (LAS float*)F.lds;
        for (int i = F.tid; i < 17 * DM; i += NTHR) { const int v = i >> 10, k = i & 1023; const float xv = v < 16 ? A.c[v * DM + k] : A.c_ctx[k]; sm[i] = siluf_(xv); }
        __syncthreads();
        LAS float* red = sm + 17 * DM;
        for (int chunk = F.blk; chunk < MODW / 24; chunk += F.nblk) {
            const int col = F.tid % 24, kg = F.tid / 24;
            float acc[17];
#pragma unroll
            for (int v = 0; v < 17; ++v) acc[v] = 0.f;
            if (kg < 21) {
#pragma unroll 7
                for (int k = kg; k < DM; k += 21) { const float w = A.ada_w[(size_t)k * MODW + chunk * 24 + col];
#pragma unroll
                    for (int v = 0; v < 17; ++v) acc[v] += sm[v * DM + k] * w; }
#pragma unroll
                for (int v = 0; v < 17; ++v) red[(kg * 17 + v) * 24 + col] = acc[v];
            }
            __syncthreads();
            if (F.tid < 17 * 24) { const int v = F.tid / 24, cc = F.tid % 24; float s = A.ada_b[chunk * 24 + cc];
                for (int g = 0; g < 21; ++g) s += red[(g * 17 + v) * 24 + cc];
                mod[v * MODW + chunk * 24 + cc] = s; }
            __syncthreads();
        }
    }
    if (F.blk == 0) for (int i = F.tid; i < 2 * HWID; i += NTHR) { const float l0 = A.lb_logits[i], l1 = A.lb_logits[2 * HWID + i]; lbo[i] = 1.0f / (1.0f + __expf(l1 - l0)); }
}

DI void p1_rows(Frame& F, const int grow0, const int NROW, const int gw, const int ngw) {
    KArgs* Ap = kargs_fresh(); KArgs& A = *Ap; const float* const mod = WSP(float, Ap, WS_MOD); bf16_t* const hout = WSP(bf16_t, Ap, WS_H);
    const int lane = F.lane;
#define P1_GROW(r_) (grow0 + (r_))
    f32x4 raw[4][4];
#define P1_LOAD(r0_) do { const int rr_ = P1_GROW(r0_); const float* src_ = rr_ < MTOK ? A.x + (size_t)rr_ * DM : A.ctx + (size_t)(rr_ - MTOK) * DM; \
        _Pragma("unroll") for (int t = 0; t < 4; ++t) _Pragma("unroll") for (int j = 0; j < 4; ++j) raw[t][j] = *(const f32x4*)(src_ + (size_t)t * DM + 4 * lane + 256 * j); } while (0)
    int r0 = gw * 4;
    if (r0 < NROW) P1_LOAD(r0);
    for (; r0 < NROW; r0 += ngw * 4) {
        const int gr0 = P1_GROW(r0);
        const int v = gr0 < MTOK ? (gr0 >> 12) : 16;
        const float* md = mod + (size_t)v * MODW;
        f32x4 xv[4][4]; float ss[4];
#pragma unroll
        for (int t = 0; t < 4; ++t) { ss[t] = 0.f;
#pragma unroll
            for (int j = 0; j < 4; ++j) { xv[t][j] = raw[t][j]; ss[t] += (xv[t][j].x * xv[t][j].x + xv[t][j].y * xv[t][j].y) + (xv[t][j].z * xv[t][j].z + xv[t][j].w * xv[t][j].w); } }
        if (r0 + ngw * 4 < NROW) P1_LOAD(r0 + ngw * 4);
        f32x4 gs[4], sh[4];
#pragma unroll
        for (int j = 0; j < 4; ++j) { const int col = 4 * lane + 256 * j; gs[j] = *(const f32x4*)(A.norm1_g + col) * (*(const f32x4*)(md + DM + col) + 1.0f); sh[j] = *(const f32x4*)(md + col); }
#pragma unroll
        for (int t = 0; t < 4; ++t) { const float rstd = rsqrtf(wave_sum(ss[t]) * (1.0f / DM) + EPS);
            bf16_t* dst = hout + (size_t)(gr0 + t) * DM;
#pragma unroll
            for (int j = 0; j < 4; ++j) { const f32x4 y = xv[t][j] * rstd * gs[j] + sh[j];
                u32x2 w; w.x = cvtpk_s(y.x, y.y); w.y = cvtpk_s(y.z, y.w); *(u32x2*)(dst + 4 * lane + 256 * j) = w; } }
    }
#undef P1_LOAD
#undef P1_GROW
}

template <int P0, int N> DI void conv_out(const f32x2 (&u)[64], const f32x2 (&tp)[CK], const f32x2 bias, bf16_t* dst, const size_t dstride) {
    if constexpr (N == 1) {
        f32x2 s = bias;
#pragma unroll
        for (int k = 0; k < CK; ++k) { const int q = P0 + k - CPAD; if (q >= 0 && q < 64) s += tp[k] * u[q]; }
        *(unsigned*)(dst + (size_t)P0 * dstride) = pk2(s.x, s.y);
    } else { conv_out<P0, N / 2>(u, tp, bias, dst, dstride); conv_out<P0 + N / 2, N - N / 2>(u, tp, bias, dst, dstride); }
}
DI void conv_item(Frame& F, int item) {
    KArgs* Ap = kargs_fresh(); KArgs& A = *Ap;
    const int lane = F.lane;
    const int nline = F.nb * 64, cg2 = item & 1, line = (item >> 1) % nline, axis = (item >> 1) / nline;
    const int b = F.b0 + (line >> 6), l = line & 63;
    const int cgp = axis * 2 + cg2, ch = cgp * 128 + 2 * lane;
    const int tok0 = b * SEQ + (axis == 0 ? l * GW : l), tstride = (axis == 0 ? 1 : GW);
    const bf16_t* const up = WSP(bf16_t, Ap, WS_PL) + fix_pl(b >> 3) / 2 + (size_t)(PL_U + cgp) * (PLANE / 2) + (size_t)tok0 * 128 + 2 * lane;
    bf16_t* const cp = WSP(bf16_t, Ap, WS_PL) + fix_pl(b >> 3) / 2 + (size_t)(PL_CPRE + cgp) * (PLANE / 2) + (size_t)tok0 * 128 + 2 * lane;
    f32x2 u[64];
#pragma unroll
    for (int p = 0; p < 64; ++p) { const unsigned uv = *(const unsigned*)(up + (size_t)p * tstride * 128); u[p].x = bflo(uv); u[p].y = bfhi(uv); }
    f32x2 tp[CK];
#pragma unroll
    for (int k = 0; k < CK; ++k) tp[k] = *(const f32x2*)(A.taps + k * CWID + ch);
    const f32x2 bias = *(const f32x2*)(A.conv_bias + ch);
    conv_out<0, 64>(u, tp, bias, cp, (size_t)tstride * 128);
}


template <int DIR, bool ISCTX>
DI f32x2 prep_pass(bf16_t* fcol, bf16_t* qsrc, bf16_t* qdst, const f32x2 lbv) {
    const f32x2 om = {1.0f - lbv.x, 1.0f - lbv.y};
    f32x2 G = {1.0f, 1.0f};
#pragma unroll 1
    for (int grp = 0; grp < 4; ++grp) {
        const int t0 = DIR ? grp * 16 : 48 - grp * 16;
        bf16_t* const fp = fcol + t0 * 128; bf16_t* const qp = qsrc + t0 * 128; bf16_t* const qd = qdst + t0 * 128;
        unsigned xw[16], qw[16];
#pragma unroll
        for (int j = 0; j < 16; ++j) { xw[j] = *(const unsigned*)(fp + j * 128); if (!ISCTX) qw[j] = *(const unsigned*)(qp + j * 128); }
#pragma unroll
        for (int i = 0; i < 16; ++i) {
            const int j = DIR ? i : 15 - i;
            f32x2 f; f.x = lbv.x + om.x * sigmoidf_(bflo(xw[j])); f.y = lbv.y + om.y * sigmoidf_(bfhi(xw[j]));
            *(unsigned*)(fp + j * 128) = cvtpk_s((1.0f - f.x) * G.x, (1.0f - f.y) * G.y);
            if (!ISCTX) {
                const float gx = __builtin_amdgcn_rcpf(fmaxf(G.x, 1e-30f)), gy = __builtin_amdgcn_rcpf(fmaxf(G.y, 1e-30f));
                *(unsigned*)(qd + j * 128) = cvtpk_s(bflo(qw[j]) * gx, bfhi(qw[j]) * gy);
            }
            G.x *= f.x; G.y *= f.y;
        }
    }
    return G;
}
DI void prep_item(Frame& F, int item) {
    KArgs* Ap = kargs_fresh(); const float* const lb = WSP(float, Ap, WS_LB); float* const earr = WSP(float, Ap, WS_EARR);
    const int lane = F.lane;
    if (item < F.nb * 64 * NH) {
        const int hh = item & 3, c = (item >> 2) & 63, b = F.b0 + (item >> 8), kc = hh * HD + 2 * lane;
        bf16_t* const t0 = WSP(bf16_t, Ap, WS_PL) + fix_pl(b >> 3) / 2 + (size_t)hh * (PLANE / 2) + (size_t)(b * SEQ + c * 64) * 128 + 2 * lane;
        float* const e0 = earr + ((size_t)((b * NH + hh) * 2) * NCHK + 4) * HD + 2 * lane;
        const f32x2 Gb = prep_pass<1, false>(t0 + (size_t)PL_FB * (PLANE / 2), t0 + (size_t)PL_Q * (PLANE / 2), t0 + (size_t)PL_QB * (PLANE / 2), *(const f32x2*)(lb + HWID + kc));
        *(f32x2*)(e0 + (size_t)(NCHK + (63 - c)) * HD) = Gb;
        const f32x2 Gf = prep_pass<0, false>(t0 + (size_t)PL_FF * (PLANE / 2), t0 + (size_t)PL_Q * (PLANE / 2), t0 + (size_t)PL_Q * (PLANE / 2), *(const f32x2*)(lb + kc));
        *(f32x2*)(e0 + (size_t)c * HD) = Gf;
    } else {
        const int it = item - F.nb * 64 * NH, hh = it & 3, c = (it >> 2) & 3, b = F.b0 + (it >> 4), kc = hh * HD + 2 * lane;
        bf16_t* const t0 = WSP(bf16_t, Ap, WS_PCTX) + (size_t)hh * (CPLANE / 2) + (size_t)(b * CTXL + c * 64) * 128 + 2 * lane;
        float* const e0 = earr + ((size_t)((b * NH + hh) * 2) * NCHK) * HD + 2 * lane;
        const f32x2 Gb = prep_pass<1, true>(t0 + (size_t)8 * (CPLANE / 2), t0, t0, *(const f32x2*)(lb + HWID + kc));
        *(f32x2*)(e0 + (size_t)(NCHK + (3 - c)) * HD) = Gb;
        const f32x2 Gf = prep_pass<0, true>(t0 + (size_t)4 * (CPLANE / 2), t0, t0, *(const f32x2*)(lb + kc));
        *(f32x2*)(e0 + (size_t)c * HD) = Gf;
    }
}

typedef short s16x4 __attribute__((ext_vector_type(4)));
DI s16x4 vtr(LAS const unsigned char* p) { return __builtin_bit_cast(s16x4, __builtin_amdgcn_ds_read_tr16_b64_v4i16((LAS s16x4*)p)); }
constexpr int SC_BUF = 41984, SC_Q = 0, SC_K = 16384, SC_V = 32768, SC_E = 40960, SC_P = 3 * SC_BUF, SC_PSTR = 144, SC_O = SC_P + 64 * SC_PSTR, SC_OSTR = 144;
static_assert(SC_O + 64 * SC_OSTR <= MISC_OFF, "scan LDS map");
DI int swV(int row) { return (((row >> 1) & 1) << 1) | (((row >> 3) & 1) << 2); }
DI int swK(int row) { return (row & 7) << 1; }
DI int swQ(int row) { return row & 15; }
DI int tile_off(int row, int colbyte, int sw) { return row * 256 + ((((colbyte >> 4) ^ sw)) << 4) + (colbyte & 15); }
#define SC_BAR() do { asm volatile("s_waitcnt lgkmcnt(0)" ::: "memory"); __builtin_amdgcn_s_barrier(); asm volatile("" ::: "memory"); } while (0)
DI constexpr int pt_tt(int W, int t) { return W == 0 ? 3 : W == 1 ? (t == 0 ? 3 : 2) : W == 2 ? (t == 0 ? 2 : 1) : 0; }
DI constexpr int pt_st(int W, int t) { return W == 0 ? t : W == 1 ? (t == 0 ? 3 : t - 1) : W == 2 ? (t == 0 ? 2 : t - 1) : 0; }
template <int W> DI void scan_ptiles(LAS unsigned char* lds, const int kb, const int qb, const int pb, const int l15, const int g) {
    constexpr int NT = W == 3 ? 1 : 3;
    int ka[4], qa[4];
#pragma unroll
    for (int ks = 0; ks < 4; ++ks) { ka[ks] = kb ^ (ks << 6); qa[ks] = qb ^ (ks << 6); }
    bf16x8 a[NT][4], bq[NT][4];
#pragma unroll
    for (int t = 0; t < NT; ++t) {
        const bool newq = (t == 0) || pt_tt(W, t) != pt_tt(W, t - 1);
#pragma unroll
        for (int ks = 0; ks < 4; ++ks) {
            a[t][ks] = *(const LAS bf16x8*)(lds + ka[ks] + pt_st(W, t) * 4096);
            if (newq) bq[t][ks] = *(const LAS bf16x8*)(lds + qa[ks] + pt_tt(W, t) * 4096); else bq[t][ks] = bq[t - 1][ks];
        }
    }
    f32x4 acc[NT];
#pragma unroll
    for (int t = 0; t < NT; ++t) acc[t] = (f32x4){0.f, 0.f, 0.f, 0.f};
#pragma unroll
    for (int ks = 0; ks < 4; ++ks)
#pragma unroll
        for (int t = 0; t < NT; ++t) acc[t] = __builtin_amdgcn_mfma_f32_16x16x32_bf16(a[t][ks], bq[t][ks], acc[t], 0, 0, 0);
#pragma unroll
    for (int t = 0; t < NT; ++t) {
        float pv[4];
#pragma unroll
        for (int r = 0; r < 4; ++r) pv[r] = (pt_tt(W, t) != pt_st(W, t) || 4 * g + r <= l15) ? acc[t][r] : 0.f;
        u32x2 pw; pw.x = cvtpk_s(pv[0], pv[1]); pw.y = cvtpk_s(pv[2], pv[3]);
        *(LAS u32x2*)(lds + pb + pt_tt(W, t) * 16 * SC_PSTR + pt_st(W, t) * 32) = pw;
    }
}
DI void scan_item(Frame& F, int item) {
    const int half = item & 1, dir = (item >> 1) & 1, hh = (item >> 2) & 3, b = F.b0 + (item >> 4), stream = (b * NH + hh) * 2 + dir;
    const int tid = F.tid, lane = F.lane, w = F.wave, l15_ = lane & 15, g_ = lane >> 4;
    KArgs* Ap = kargs_fresh();
    LAS unsigned char* const lds = F.lds;
    const unsigned char* const plb = (const unsigned char*)WSP(bf16_t, Ap, WS_PL) + fix_pl(b >> 3) + (size_t)hh * PLANE + (size_t)b * SEQ * 256;
    const unsigned char* const pcb = (const unsigned char*)WSP(bf16_t, Ap, WS_PCTX) + (size_t)hh * CPLANE + (size_t)b * CTXL * 256;
    const unsigned char* const earrb = (const unsigned char*)(WSP(float, Ap, WS_EARR) + (size_t)stream * NCHK * HD);
    bf16_t* const obase = WSP(bf16_t, Ap, WS_PL) + fix_pl(b >> 3) / 2 + (size_t)((dir ? PL_OB : PL_OF) + hh) * (PLANE / 2) + (size_t)b * SEQ * 128 + 64 * half;
    const int vcol = 64 * half + 16 * (w & 3);
    for (int i = tid; i < 64 * SC_PSTR / 4; i += NTHR) *(LAS unsigned*)(lds + SC_P + 4 * i) = 0u;
    f32x4 S[8];
#pragma unroll
    for (int i = 0; i < 8; ++i) S[i] = (f32x4){0.f, 0.f, 0.f, 0.f};
#define SC_DMA(ci_, bi_) do { const int ci__ = (ci_); const int bo_ = (bi_) * SC_BUF; const bool cx = ci__ < 4; const int c64 = (cx ? ci__ : ci__ - 4) * 64; const int pw_ = w - 4; \
        const unsigned char* rb = cx ? pcb : plb; const int nrow = cx ? CTXL : SEQ; \
        const size_t koff = cx ? (size_t)(dir ? 8 : 4) * CPLANE : (size_t)(dir ? PL_FB : PL_FF) * PLANE, voff = cx ? 0 : (size_t)PL_I * PLANE, qoff = cx ? koff : (size_t)(dir ? PL_QB : PL_Q) * PLANE; \
        _Pragma("unroll") for (int pc = 0; pc < 4; ++pc) { const int inst = 4 * pw_ + pc, row = inst * 4 + g_; const int pos = c64 + row, n = dir ? (nrow - 1 - pos) : pos; \
            const unsigned char* rp = rb + (size_t)n * 256; \
            __builtin_amdgcn_global_load_lds((const unsigned*)(rp + qoff + ((l15_ ^ swQ(row)) << 4)), (LAS unsigned*)(lds + bo_ + SC_Q + inst * 1024), 16, 0, 0); \
            __builtin_amdgcn_global_load_lds((const unsigned*)(rp + koff + ((l15_ ^ swK(row)) << 4)), (LAS unsigned*)(lds + bo_ + SC_K + inst * 1024), 16, 0, 0); } \
        _Pragma("unroll") for (int pc = 0; pc < 2; ++pc) { const int vi = 2 * pw_ + pc, row = vi * 8 + (lane >> 3), pos = c64 + row, n = dir ? (nrow - 1 - pos) : pos; \
          __builtin_amdgcn_global_load_lds((const unsigned*)(rb + (size_t)n * 256 + voff + 128 * half + (((lane & 7) ^ swV(row)) << 4)), (LAS unsigned*)(lds + bo_ + SC_V + vi * 1024), 16, 0, 0); } \
        __builtin_amdgcn_global_load_lds((const unsigned*)(earrb + (size_t)ci__ * (HD * 4) + ((lane & 31) << 4)), (LAS unsigned*)(lds + bo_ + SC_E), 16, 0, 0); \
    } while (0)
    if (w >= 4) { SC_DMA(0, 0); SC_DMA(1, 1); }
    int bi = 0;
    for (int ci = 0; ci < NCHK; ++ci) {
        int l15 = l15_, g = g_;
        asm volatile("" : "+v"(l15), "+v"(g));
        if (w >= 4) { if (ci + 2 < NCHK) asm volatile("s_waitcnt vmcnt(11)" ::: "memory"); else asm volatile("s_waitcnt vmcnt(0)" ::: "memory"); }
        SC_BAR();
        if (w >= 4 && ci + 2 < NCHK) { const int b2 = bi == 0 ? 2 : bi - 1; SC_DMA(ci + 2, b2); }
        const bool lat = ci >= 4;
        const int bo = bi * SC_BUF;
        bi = bi == 2 ? 0 : bi + 1;
        if (w < 4 && ci >= 5) {
#pragma unroll
            for (int k = 0; k < 2; ++k) { const int row = (tid >> 3) + 32 * k, ch = tid & 7, pos = (ci - 5) * 64 + row, n = dir ? (SEQ - 1 - pos) : pos;
                *(u32x4*)(obase + (size_t)n * 128 + ch * 8) = *(const LAS u32x4*)(lds + SC_O + row * SC_OSTR + ch * 16); }
        }
        f32x4 OT[4]; bf16x8 vf[2], kq[3][2]; int kvb = 0;
        if (w >= 4) {
            if (lat) {
                const int kb = bo + SC_K + l15 * 256 + ((g ^ ((l15 & 7) << 1)) << 4), qb = bo + SC_Q + l15 * 256 + ((g ^ l15) << 4), pb = SC_P + l15 * SC_PSTR + 8 * g;
                if (w == 4) scan_ptiles<0>(lds, kb, qb, pb, l15, g); else if (w == 5) scan_ptiles<1>(lds, kb, qb, pb, l15, g); else if (w == 6) scan_ptiles<2>(lds, kb, qb, pb, l15, g); else scan_ptiles<3>(lds, kb, qb, pb, l15, g);
            }
        } else {
            const LAS float* Ev = (const LAS float*)(lds + bo + SC_E);
#pragma unroll
            for (int i = 0; i < 8; ++i) S[i] = S[i] * *(const LAS f32x4*)(Ev + 16 * i + 4 * g);
            if (lat) {
                bf16x8 sa[4];
#pragma unroll
                for (int i2 = 0; i2 < 4; ++i2) { u32x4 pk; pk.x = cvtpk_s(S[2 * i2][0], S[2 * i2][1]); pk.y = cvtpk_s(S[2 * i2][2], S[2 * i2][3]); pk.z = cvtpk_s(S[2 * i2 + 1][0], S[2 * i2 + 1][1]); pk.w = cvtpk_s(S[2 * i2 + 1][2], S[2 * i2 + 1][3]);
                    sa[i2] = __builtin_bit_cast(bf16x8, pk); }
#pragma unroll
                for (int j = 0; j < 4; ++j) OT[j] = (f32x4){0.f, 0.f, 0.f, 0.f};
                bf16x8 qf[2][4];
                const int qv = bo + SC_Q + l15 * 256 + ((((g >> 1) ^ l15)) << 4) + 8 * (g & 1);
#define SC_LDQ(dst, i2_) do { const int qlo_ = qv ^ ((4 * (i2_)) << 4), qhi_ = qv ^ ((4 * (i2_) + 2) << 4); _Pragma("unroll") for (int j = 0; j < 4; ++j) { \
                    const u32x2 lo = *(const LAS u32x2*)(lds + qlo_ + j * 4096), hi = *(const LAS u32x2*)(lds + qhi_ + j * 4096); \
                    u32x4 bb; bb.x = lo.x; bb.y = lo.y; bb.z = hi.x; bb.w = hi.y; dst[j] = __builtin_bit_cast(bf16x8, bb); } } while (0)
                SC_LDQ(qf[0], 0);
#pragma unroll
                for (int i2 = 0; i2 < 4; ++i2) {
                    if (i2 + 1 < 4) SC_LDQ(qf[(i2 + 1) & 1], i2 + 1);
#pragma unroll
                    for (int j = 0; j < 4; ++j) OT[j] = __builtin_amdgcn_mfma_f32_16x16x32_bf16(sa[i2], qf[i2 & 1][j], OT[j], 0, 0, 0);
                }
#undef SC_LDQ
            }
            {
                const int qq = l15 >> 2, pp = l15 & 3;
                const int cb = 32 * (w & 3) + 8 * pp;
                const int vv = bo + SC_V + (8 * g + qq) * 128 + ((((cb >> 4) ^ swV(8 * g + qq))) << 4) + (cb & 15);
#pragma unroll
                for (int ks = 0; ks < 2; ++ks) { const s16x4 lo = vtr(lds + vv + ks * 4096), hi = vtr(lds + vv + ks * 4096 + 512);
                    vf[ks] = __builtin_shufflevector(lo, hi, 0, 1, 2, 3, 4, 5, 6, 7); }
                kvb = bo + SC_K + g * 2048 + qq * 256 + ((((pp >> 1) ^ (2 * qq))) << 4) + 8 * (pp & 1);
#define SC_LDK(dst, i_) do { const int k0_ = kvb ^ ((i_) << 5), k1_ = kvb ^ ((((i_) ^ 4)) << 5); _Pragma("unroll") for (int ks = 0; ks < 2; ++ks) { \
                    const s16x4 lo = vtr(lds + k0_ + ks * 8192), hi = vtr(lds + k1_ + ks * 8192 + 1024); \
                    dst[ks] = __builtin_shufflevector(lo, hi, 0, 1, 2, 3, 4, 5, 6, 7); } } while (0)
                SC_LDK(kq[0], 0); SC_LDK(kq[1], 1); SC_LDK(kq[2], 2);
            }
        }
        SC_BAR();
        if (w < 4) {
            if (lat) {
                bf16x8 pb[4][2];
#pragma unroll
                for (int j = 0; j < 4; ++j)
#pragma unroll
                    for (int ks = 0; ks < 2; ++ks) { if (32 * ks > 16 * j + 15) continue; pb[j][ks] = *(const LAS bf16x8*)(lds + SC_P + (16 * j + l15) * SC_PSTR + (32 * ks + 8 * g) * 2); }
#pragma unroll
                for (int j = 0; j < 4; ++j) {
#pragma unroll
                    for (int ks = 0; ks < 2; ++ks) { if (32 * ks > 16 * j + 15) continue; OT[j] = __builtin_amdgcn_mfma_f32_16x16x32_bf16(vf[ks], pb[j][ks], OT[j], 0, 0, 0); }
                    u32x2 ow; ow.x = cvtpk_s(OT[j][0], OT[j][1]); ow.y = cvtpk_s(OT[j][2], OT[j][3]);
                    *(LAS u32x2*)(lds + SC_O + (16 * j + l15) * SC_OSTR + (16 * (w & 3) + 4 * g) * 2) = ow;
                }
            }
            {
                const int qq = l15 >> 2, pp = l15 & 3;
#pragma unroll
                for (int i = 0; i < 8; ++i) {
                    S[i] = __builtin_amdgcn_mfma_f32_16x16x32_bf16(kq[i % 3][0], vf[0], S[i], 0, 0, 0);
                    S[i] = __builtin_amdgcn_mfma_f32_16x16x32_bf16(kq[i % 3][1], vf[1], S[i], 0, 0, 0);
                    if (i + 3 < 8) SC_LDK(kq[i % 3], i + 3);
                }
            }
#undef SC_LDK
        }
    }
    SC_BAR();
    if (w < 4) {
#pragma unroll
        for (int k = 0; k < 2; ++k) { const int row = (tid >> 3) + 32 * k, ch = tid & 7, pos = (NCHK - 5) * 64 + row, n = dir ? (SEQ - 1 - pos) : pos;
            *(u32x4*)(obase + (size_t)n * 128 + ch * 8) = *(const LAS u32x4*)(lds + SC_O + row * SC_OSTR + ch * 16); }
    }
    asm volatile("s_waitcnt vmcnt(0)" ::: "memory");
    SC_BAR();
#undef SC_DMA
}

DI void p4_mixed(Frame& F, const int tbeg, const int tend, const int gw, const int ngw) {
    KArgs* Ap = kargs_fresh(); KArgs& A = *Ap;
    bf16_t* const mixed = WSP(bf16_t, Ap, WS_H);
    const int lane = F.lane;
    const bf16_t* const plq = WSP(bf16_t, Ap, WS_PL) + fix_pl(tbeg >> 15) / 2 + (size_t)(lane >> 4) * (PLANE / 2) + (lane & 15) * 8;
    float lng[8], lnb[8], hg[8];
    { const f32x4 a0 = *(const f32x4*)(A.ln_g + 8 * lane), a1 = *(const f32x4*)(A.ln_g + 8 * lane + 4), b0 = *(const f32x4*)(A.ln_b + 8 * lane), b1 = *(const f32x4*)(A.ln_b + 8 * lane + 4), c0 = *(const f32x4*)(A.hgrn_g + 8 * lane), c1 = *(const f32x4*)(A.hgrn_g + 8 * lane + 4);
#pragma unroll
      for (int j = 0; j < 4; ++j) { lng[j] = a0[j]; lng[4 + j] = a1[j]; lnb[j] = b0[j]; lnb[4 + j] = b1[j]; hg[j] = c0[j]; hg[4 + j] = c1[j]; } }
    u32x4 rc[4], rf[4], rb[4], rg[4];
#define P5_LOAD(t0_) do { _Pragma("unroll") for (int t = 0; t < 4; ++t) { const size_t ro = (size_t)((t0_) + t) * 128; \
        rc[t] = *(const u32x4*)(plq + (size_t)PL_CPRE * (PLANE / 2) + ro); rf[t] = *(const u32x4*)(plq + (size_t)PL_OF * (PLANE / 2) + ro); \
        rb[t] = *(const u32x4*)(plq + (size_t)PL_OB * (PLANE / 2) + ro); rg[t] = *(const u32x4*)(plq + (size_t)PL_G * (PLANE / 2) + ro); } } while (0)
    if (tbeg + gw * 4 < tend) P5_LOAD(tbeg + gw * 4);
    for (int t0 = tbeg + gw * 4; t0 < tend; t0 += ngw * 4) {
        u32x4 cw[4], fw[4], bw[4], gw4[4];
#pragma unroll
        for (int t = 0; t < 4; ++t) { cw[t] = rc[t]; fw[t] = rf[t]; bw[t] = rb[t]; gw4[t] = rg[t]; }
        if (t0 + ngw * 4 < tend) P5_LOAD(t0 + ngw * 4);
#pragma unroll
        for (int t = 0; t < 4; ++t) {
            float cv[8] = {bflo(cw[t].x), bfhi(cw[t].x), bflo(cw[t].y), bfhi(cw[t].y), bflo(cw[t].z), bfhi(cw[t].z), bflo(cw[t].w), bfhi(cw[t].w)};
            float sm = 0.f;
#pragma unroll
            for (int j = 0; j < 8; ++j) sm += cv[j];
            const float mu = wave_sum(sm) * (1.0f / CWID); float q = 0.f;
#pragma unroll
            for (int j = 0; j < 8; ++j) { cv[j] -= mu; q += cv[j] * cv[j]; }
            const float rstd = rsqrtf(wave_sum(q) * (1.0f / CWID) + EPS);
            float r[8];
#pragma unroll
            for (int j = 0; j < 8; ++j) r[j] = siluf_(cv[j] * rstd * lng[j] + lnb[j]);
            u32x4 w; w.x = cvtpk_s(r[0], r[1]); w.y = cvtpk_s(r[2], r[3]); w.z = cvtpk_s(r[4], r[5]); w.w = cvtpk_s(r[6], r[7]);
            *(u32x4*)(mixed + (size_t)(t0 + t) * DM + 8 * lane) = w;
            const float o[8] = {bflo(fw[t].x) + bflo(bw[t].x), bfhi(fw[t].x) + bfhi(bw[t].x), bflo(fw[t].y) + bflo(bw[t].y), bfhi(fw[t].y) + bfhi(bw[t].y), bflo(fw[t].z) + bflo(bw[t].z), bfhi(fw[t].z) + bfhi(bw[t].z), bflo(fw[t].w) + bflo(bw[t].w), bfhi(fw[t].w) + bfhi(bw[t].w)};
            const float gt[8] = {bflo(gw4[t].x), bfhi(gw4[t].x), bflo(gw4[t].y), bfhi(gw4[t].y), bflo(gw4[t].z), bfhi(gw4[t].z), bflo(gw4[t].w), bfhi(gw4[t].w)};
            float ss = 0.f;
#pragma unroll
            for (int j = 0; j < 8; ++j) ss += o[j] * o[j];
            ss += __shfl_xor(ss, 1); ss += __shfl_xor(ss, 2); ss += __shfl_xor(ss, 4); ss += __shfl_xor(ss, 8);
            const float rs = rsqrtf(ss * (1.0f / HD) + EPS);
#pragma unroll
            for (int j = 0; j < 8; ++j) r[j] = o[j] * rs * hg[j] * siluf_(gt[j]);
            w.x = cvtpk_s(r[0], r[1]); w.y = cvtpk_s(r[2], r[3]); w.z = cvtpk_s(r[4], r[5]); w.w = cvtpk_s(r[6], r[7]);
            *(u32x4*)(mixed + (size_t)(t0 + t) * DM + CWID + 8 * lane) = w;
        }
    }
#undef P5_LOAD
}

DI void p6_rows(Frame& F) {
    KArgs* Ap = kargs_fresh(); KArgs& A = *Ap; const float* const mod = WSP(float, Ap, WS_MOD); unsigned char* const h20 = WSP(unsigned char, Ap, WS_H2); float* const probs = WSP(float, Ap, WS_PROBS); const bf16_t* const mix0 = WSP(bf16_t, Ap, WS_MIX);
    const int lane = F.lane, tid = F.tid;
    LAS float* rw = (LAS float*)F.lds;
    LAS float* ps = (LAS float*)(F.lds + 65536);
    for (int i = tid; i < DM * NE / 4; i += NTHR) { const int col = i >> 2, e4 = i & 3, l = (col & 255) >> 2, cc = col & 3, j = col >> 8;
        *(LAS f32x4*)(rw + ((((j * 4 + cc) * 4 + e4) * 64 + l) << 2)) = *(const f32x4*)(A.router + 4 * i); }
    __syncthreads();
    for (int tile = F.b0 * 16 + F.blk; tile < (F.b0 + F.nb) * 16; tile += F.nblk) {
        const int b = tile >> 4; const float* md = mod + (size_t)b * MODW;
        unsigned char* const h2 = h20 + fix_h2(tile >> 7); const bf16_t* const mix = mix0 + fix_mix(tile >> 7) / 2;
        f32x4 gg[4], sh[4];
#pragma unroll
        for (int j = 0; j < 4; ++j) { const int col = 4 * lane + 256 * j; gg[j] = *(const f32x4*)(A.norm2_g + col) * (*(const f32x4*)(md + 4 * DM + col) + 1.0f); sh[j] = *(const f32x4*)(md + 3 * DM + col); }
        u32x2 mr[2][4];
#define P6_LOAD(it_) do { const int tk_ = tile * 256 + (it_) * 16 + F.wave * 2; _Pragma("unroll") for (int t = 0; t < 2; ++t) _Pragma("unroll") for (int j = 0; j < 4; ++j) { \
            const size_t eo = (size_t)(tk_ + t) * DM + 4 * lane + 256 * j; mr[t][j] = *(const u32x2*)(mix + eo); } } while (0)
        P6_LOAD(0);
#pragma unroll 1
        for (int it = 0; it < 16; ++it) {
            const int tl = it * 16 + F.wave * 2, tok0 = tile * 256 + tl;
            f32x4 y[2][4]; float ss[2];
#pragma unroll
            for (int t = 0; t < 2; ++t) { ss[t] = 0.f;
#pragma unroll
                for (int j = 0; j < 4; ++j) { const f32x4 mv = {bflo(mr[t][j].x), bfhi(mr[t][j].x), bflo(mr[t][j].y), bfhi(mr[t][j].y)};
                    y[t][j] = mv; ss[t] += (y[t][j].x * y[t][j].x + y[t][j].y * y[t][j].y) + (y[t][j].z * y[t][j].z + y[t][j].w * y[t][j].w); } }
            if (it + 1 < 16) P6_LOAD(it + 1);
#pragma unroll
            for (int t = 0; t < 2; ++t) { const float rstd = rsqrtf(wave_sum(ss[t]) * (1.0f / DM) + EPS);
#pragma unroll
                for (int j = 0; j < 4; ++j) { y[t][j] = y[t][j] * rstd * gg[j] + sh[j];
                    *(unsigned*)(h2 + (size_t)(tok0 + t) * DM + 4 * lane + 256 * j) = pk4_fp8(y[t][j].x, y[t][j].y, y[t][j].z, y[t][j].w); } }
            float lg[32];
#pragma unroll
            for (int i = 0; i < 32; ++i) lg[i] = 0.f;
#pragma unroll
            for (int j = 0; j < 4; ++j)
#pragma unroll
                for (int cc = 0; cc < 4; ++cc) {
                    f32x4 r4[4];
#pragma unroll
                    for (int e4 = 0; e4 < 4; ++e4) r4[e4] = *(const LAS f32x4*)(rw + ((((j * 4 + cc) * 4 + e4) * 64 + lane) << 2));
#pragma unroll
                    for (int t = 0; t < 2; ++t)
#pragma unroll
                        for (int e4 = 0; e4 < 4; ++e4)
#pragma unroll
                            for (int q = 0; q < 4; ++q) lg[t * 16 + e4 * 4 + q] += y[t][j][cc] * r4[e4][q];
                }
#define P6_BFLY(off, lb) do { const bool up = (lane & (lb)) != 0; _Pragma("unroll") for (int i = 0; i < (off); ++i) { const float keep = up ? lg[i + (off)] : lg[i], send = up ? lg[i] : lg[i + (off)]; lg[i] = keep + __shfl_xor(send, (lb)); } } while (0)
            P6_BFLY(16, 32); P6_BFLY(8, 16); P6_BFLY(4, 8); P6_BFLY(2, 4); P6_BFLY(1, 2);
#undef P6_BFLY
            float v = lg[0] + __shfl_xor(lg[0], 1), mx = v;
#pragma unroll
            for (int o = 2; o < 32; o <<= 1) mx = fmaxf(mx, __shfl_xor(mx, o));
            const float ev = __expf(v - mx); float den = ev;
#pragma unroll
            for (int o = 2; o < 32; o <<= 1) den += __shfl_xor(den, o);
            if (!(lane & 1)) ps[((lane >> 1) & 15) * 256 + tl + (lane >> 5)] = ev * __builtin_amdgcn_rcpf(den);
        }
#undef P6_LOAD
        __syncthreads();
        { const int n0 = (tile & 15) * 256;
#pragma unroll
          for (int k = 0; k < 2; ++k) { const int i = tid + NTHR * k, e = i >> 6, c4 = (i & 63) * 4;
              *(f32x4*)(probs + ((size_t)(b * NE + e)) * SEQ + n0 + c4) = *(const LAS f32x4*)(ps + e * 256 + c4); } }
        __syncthreads();
    }
}

DI void topk_item(Frame& F, int g) {
    const int tid = F.tid, lane = F.lane, wave = F.wave;
    LAS int* hist = (LAS int*)F.lds; LAS int* scan = hist + 256; LAS int* misc = scan + 256;
    KArgs* Ap = kargs_fresh(); int* const idx = WSP(int, Ap, WS_IDX); float* const gate = WSP(float, Ap, WS_GATE); int* const sel = WSP(int, Ap, WS_SEL);
    const float* pr = WSP(float, Ap, WS_PROBS) + (size_t)g * SEQ + tid * 8;
    const u32x4 p0 = *(const u32x4*)pr, p1 = *(const u32x4*)(pr + 4);
    const unsigned u[8] = {p0.x, p0.y, p0.z, p0.w, p1.x, p1.y, p1.z, p1.w};
    unsigned prefix = 0; int need = CAP;
    for (int pass = 0; pass < 4; ++pass) {
        const int shift = 24 - 8 * pass;
        __syncthreads();
        if (tid < 256) hist[tid] = 0;
        __syncthreads();
#pragma unroll
        for (int j = 0; j < 8; ++j) { const bool match = (pass == 0) || ((u[j] >> (shift + 8)) == prefix);
            if (match) __hip_atomic_fetch_add(hist + ((u[j] >> shift) & 255u), 1, __ATOMIC_RELAXED, __HIP_MEMORY_SCOPE_WORKGROUP); }
        __syncthreads();
        if (wave == 0) {
            const int h0 = hist[4 * lane], h1 = hist[4 * lane + 1], h2 = hist[4 * lane + 2], h3 = hist[4 * lane + 3];
            const int s3 = h3, s2 = h2 + s3, s1 = h1 + s2, s0 = h0 + s1;
            int inc = s0;
#pragma unroll
            for (int o = 1; o < 64; o <<= 1) { const int t = __shfl_down(inc, o); if (lane + o < 64) inc += t; }
            const int above = inc - s0;
            scan[4 * lane] = s0 + above; scan[4 * lane + 1] = s1 + above; scan[4 * lane + 2] = s2 + above; scan[4 * lane + 3] = s3 + above;
        }
        __syncthreads();
        if (tid < 256) { const int incl = scan[tid], above = (tid < 255) ? scan[tid + 1] : 0; if (incl >= need && above < need) { misc[0] = tid; misc[1] = above; } }
        __syncthreads();
        prefix = (prefix << 8) | (unsigned)misc[0]; need -= misc[1];
    }
    const unsigned T = prefix;
    int cg = 0, ce = 0;
#pragma unroll
    for (int j = 0; j < 8; ++j) { cg += (u[j] > T); ce += (u[j] == T); }
    int pk = cg | (ce << 16), inc = pk;
#pragma unroll
    for (int o = 1; o < 64; o <<= 1) { const int t = __shfl_up(inc, o); if (lane >= o) inc += t; }
    __syncthreads();
    if (lane == 63) misc[8 + wave] = inc;
    __syncthreads();
    int base = 0;
#pragma unroll
    for (int w = 0; w < NWAVES; ++w) if (w < wave) base += misc[8 + w];
    const int excl = base + inc - pk; int rg = excl & 0xffff, re = excl >> 16;
    const int cgt = CAP - need;
    const int b = g >> 4, e = g & 15;
#pragma unroll
    for (int j = 0; j < 8; ++j) { const int n = tid * 8 + j; int slot = -1;
        if (u[j] > T) { slot = rg; ++rg; } else if (u[j] == T) { if (re < need) slot = cgt + re; ++re; }
        if (slot >= 0) { idx[g * CAP + slot] = n; gate[g * CAP + slot] = __uint_as_float(u[j]); }
        sel[((size_t)(b * SEQ + n)) * NE + e] = slot; }
}

DI void p10_final(Frame& F) {
    KArgs* Ap = kargs_fresh(); KArgs& A = *Ap; const float* const mod = WSP(float, Ap, WS_MOD); const int* const sel = WSP(int, Ap, WS_SEL); const bf16_t* const mout0 = WSP(bf16_t, Ap, WS_MOUT); const bf16_t* const mix0 = WSP(bf16_t, Ap, WS_MIX); const float* const gate = WSP(float, Ap, WS_GATE);
    const int gw = F.blk * NWAVES + F.wave, ngw = F.nblk * NWAVES, lane = F.lane;
    const int tbeg = F.b0 * SEQ, tend = (F.b0 + F.nb) * SEQ;
    int svn = (tbeg + gw < tend && lane < NE) ? sel[(size_t)(tbeg + gw) * NE + lane] : -1;
    for (int tok = tbeg + gw; tok < tend; tok += ngw) {
        const int b = tok >> 12; const float* md = mod + (size_t)b * MODW + 5 * DM;
        const bf16_t* const mout = mout0 + fix_mout(b >> 3) / 2; const bf16_t* const mix = mix0 + fix_mix(b >> 3) / 2;
        const int sv = svn;
        if (tok + ngw < tend) svn = (lane < NE) ? sel[(size_t)(tok + ngw) * NE + lane] : -1;
        float* xr = A.out + (size_t)tok * DM;
        u32x4 mw2[2];
#pragma unroll
        for (int hlf = 0; hlf < 2; ++hlf) mw2[hlf] = *(const u32x4*)(mix + (size_t)tok * DM + hlf * 512 + 8 * lane);
        float y[16];
#pragma unroll
        for (int j = 0; j < 16; ++j) y[j] = 0.f;
#pragma unroll
        for (int e = 0; e < NE; ++e) { const int s = __builtin_amdgcn_readlane(sv, e);
            if (s >= 0) { const size_t ri = (size_t)(b * NE + e) * CAP + s; const bf16_t* row = mout + ri * DM;
                const float gt = __hip_atomic_load(gate + ri, __ATOMIC_RELAXED, __HIP_MEMORY_SCOPE_AGENT);
                const u32x4 w0 = *(const u32x4*)(row + 8 * lane), w1 = *(const u32x4*)(row + 512 + 8 * lane);
                y[0] += gt * bflo(w0.x); y[1] += gt * bfhi(w0.x); y[2] += gt * bflo(w0.y); y[3] += gt * bfhi(w0.y); y[4] += gt * bflo(w0.z); y[5] += gt * bfhi(w0.z); y[6] += gt * bflo(w0.w); y[7] += gt * bfhi(w0.w);
                y[8] += gt * bflo(w1.x); y[9] += gt * bfhi(w1.x); y[10] += gt * bflo(w1.y); y[11] += gt * bfhi(w1.y); y[12] += gt * bflo(w1.z); y[13] += gt * bfhi(w1.z); y[14] += gt * bflo(w1.w); y[15] += gt * bfhi(w1.w); } }
        float xf[16]; float ss = 0.f;
#pragma unroll
        for (int hlf = 0; hlf < 2; ++hlf) { const u32x4 mw = mw2[hlf];
            const float mv[8] = {bflo(mw.x), bfhi(mw.x), bflo(mw.y), bfhi(mw.y), bflo(mw.z), bfhi(mw.z), bflo(mw.w), bfhi(mw.w)};
#pragma unroll
            for (int q = 0; q < 2; ++q) { const int col = hlf * 512 + 8 * lane + 4 * q; const f32x4 g2 = *(const f32x4*)(md + col);
#pragma unroll
                for (int j = 0; j < 4; ++j) { const float t = mv[q * 4 + j] + g2[j] * y[hlf * 8 + q * 4 + j]; xf[hlf * 8 + q * 4 + j] = t; ss += t * t; } } }
        const float rstd = rsqrtf(wave_sum(ss) * (1.0f / DM) + EPS);
#pragma unroll
        for (int hlf = 0; hlf < 2; ++hlf)
#pragma unroll
            for (int q = 0; q < 2; ++q) { const int col = hlf * 512 + 8 * lane + 4 * q; const f32x4 fg = *(const f32x4*)(A.final_g + col); f32x4 o;
#pragma unroll
                for (int j = 0; j < 4; ++j) o[j] = xf[hlf * 8 + q * 4 + j] * rstd * fg[j];
                *(f32x4*)(xr + col) = o; }
    }
}

constexpr int CW_CTX = 96;
DI void block_handoff(Frame& F) { asm volatile("s_waitcnt vmcnt(0)" ::: "memory"); __syncthreads(); if (F.tid == 0) { __builtin_amdgcn_fence(__ATOMIC_ACQUIRE, "agent"); asm volatile("s_waitcnt vmcnt(0)" ::: "memory"); } __syncthreads(); frame_refresh(F); }
constexpr int CW_WFLAG = 64;
__global__ void __launch_bounds__(NTHR, 2) hymba_fwd(Args args) {
    extern __shared__ __attribute__((aligned(16))) unsigned char lds_raw[];
    Frame F;
    F.lds = (LAS unsigned char*)lds_raw; F.wave = __builtin_amdgcn_readfirstlane((int)threadIdx.x >> 6); frame_refresh(F);
    const int gblk = blockIdx.x, gn = gridDim.x;
    const int nl = (gn % 16 == 0) ? N_LANES : 1;
    const int lid = nl == 2 ? ((gblk >> 3) & 1) : 0, lblk = nl == 2 ? ((gblk & 7) | ((gblk >> 4) << 3)) : gblk, lnblk = gn / nl;
    volatile LAS unsigned* MISC = (volatile LAS unsigned*)(F.lds + MISC_OFF);
    if (F.tid < 32) MISC[F.tid] = 0u;
    __syncthreads();
    unsigned* const ctl = (unsigned*)(args.ws + WS_CTL);
    XcdBarrier gbar = xcd_barrier_post(ctl + 4096, MISC + 8, F.tid == 0, (unsigned)gn);
    XcdBarrier lbar = xcd_barrier_post(ctl + 4096 + (1 + lid) * XCD_BAR_WORDS, MISC + 10, F.tid == 0, (unsigned)lnblk);
#define LBAR() do { frame_refresh(F); xcd_barrier(lbar, F.tid == 0); frame_refresh(F); } while (0)

    F.blk = gblk; F.nblk = gn; F.b0 = 0; F.nb = NB;
    p0_prologue(F); __syncthreads(); p0_transposes<0>(F);
    frame_refresh(F); xcd_barrier(gbar, F.tid == 0); frame_refresh(F);

    F.blk = lblk; F.nblk = lnblk; F.nb = NB / nl; F.b0 = lid * F.nb;
    if (lid == nl - 1) {
        p0_transposes<1>(F);
        LBAR();
        if (lblk == 0 && F.tid == 0) __hip_atomic_store(ctl + CW_WFLAG, 1u, __ATOMIC_RELAXED, __HIP_MEMORY_SCOPE_AGENT);
    }
    p1_rows(F, MTOK + F.b0 * CTXL, F.nb * CTXL, F.blk * NWAVES + F.wave, F.nblk * NWAVES);
    block_handoff(F);
    if (F.tid == 0) { __builtin_amdgcn_fence(__ATOMIC_RELEASE, "agent"); asm volatile("s_waitcnt vmcnt(0)" ::: "memory"); (void)xb_add(ctl + CW_CTX + lid, 1u); }
    for (int tile = F.b0 * 16 + F.blk; tile < (F.b0 + F.nb) * 16; tile += F.nblk) p1_rows(F, tile * 256, 256, F.wave, NWAVES);
    block_handoff(F);
    { KArgs* Ap = kargs_fresh(); ProbDense P; P.A = WSP(bf16_t, Ap, WS_H); P.Bt = WSP(bf16_t, Ap, WS_WIN); P.K = DM; P.ord.init_own(F.nb * 16, INC / 256, F.nblk, F.blk, F.b0 * 16);
      EpiPlanes E{WSP(bf16_t, Ap, WS_PL)}; pg8::gemm_phase<ProbDense, EpiPlanes, true>(F.lds, F.tid, P, E); }
    frame_refresh(F);
    {
        if (F.tid == 0) { unsigned sp = 0; while (xb_ld(ctl + CW_CTX + lid) < (unsigned)F.nblk) { __builtin_amdgcn_s_sleep(8); if (++sp > (1u << 22)) break; }
            __builtin_amdgcn_fence(__ATOMIC_ACQUIRE, "agent"); asm volatile("s_waitcnt vmcnt(0)" ::: "memory"); }
        __syncthreads();
        KArgs* Ap = kargs_fresh(); ProbDense P; P.A = WSP(bf16_t, Ap, WS_H) + (size_t)MTOK * DM; P.Bt = WSP(bf16_t, Ap, WS_WIN) + (size_t)OFF_I * DM; P.K = DM; P.ord.init(F.nb, PCW / 256, F.nblk, F.blk, F.b0);
        EpiCtxPlanes E{WSP(bf16_t, Ap, WS_PCTX)}; pg8::gemm_phase<ProbDense, EpiCtxPlanes, true>(F.lds, F.tid, P, E);
    }
    LBAR();
    {
        const int gwv = F.blk * NWAVES + F.wave, ngw = F.nblk * NWAVES, nconv = F.nb * 64 * 2 * 2, nprep = F.nb * 64 * NH + F.nb * 4 * NH;
        const bool prep_first = F.wave >= 4;
        if (prep_first) for (int it = gwv; it < nprep; it += ngw) prep_item(F, it);
        for (int it = gwv; it < nconv; it += ngw) conv_item(F, it);
        if (!prep_first) for (int it = gwv; it < nprep; it += ngw) prep_item(F, it);
    }
    LBAR();
    {
        const int nscan = F.nb * NH * 2 * 2;
        for (int it = F.blk; it < nscan; it += F.nblk) { const int x = it & 7, y = it >> 3; scan_item(F, ((x + 8 * (y >> 1)) << 1) | (y & 1)); }
    }
    LBAR();
    for (int tile = F.b0 * 16 + F.blk; tile < (F.b0 + F.nb) * 16; tile += F.nblk) p4_mixed(F, tile * 256, tile * 256 + 256, F.wave, NWAVES);
    block_handoff(F);
    { KArgs* Ap = kargs_fresh(); ProbDense P; P.A = WSP(bf16_t, Ap, WS_H); P.Bt = WSP(bf16_t, Ap, WS_WOUT); P.K = DM; P.ord.init_own(F.nb * 16, DM / 256, F.nblk, F.blk, F.b0 * 16);
      EpiX1 E{WSP(bf16_t, Ap, WS_MIX), Ap->x, WSP(float, Ap, WS_MOD)}; pg8::gemm_phase<ProbDense, EpiX1, true>(F.lds, F.tid, P, E); }
    block_handoff(F);
    p6_rows(F);
    LBAR();
    {
        if (F.tid == 0) { unsigned sp = 0; while (__hip_atomic_load(ctl + CW_WFLAG, __ATOMIC_RELAXED, __HIP_MEMORY_SCOPE_AGENT) == 0u) { __builtin_amdgcn_s_sleep(8); if (++sp > (1u << 22)) break; }
            __builtin_amdgcn_fence(__ATOMIC_ACQUIRE, "agent"); asm volatile("s_waitcnt vmcnt(0)" ::: "memory"); }
        __syncthreads();
    }
    for (int gl = F.blk; gl < F.nb * NE; gl += F.nblk) {
        const int e = 2 * (gl & 7) + ((gl >> 3) & 1), b = F.b0 + (gl >> 4), g = b * NE + e, gm = e * 32 + b * 2;
        topk_item(F, g);
        block_handoff(F);
        { KArgs* Ap = kargs_fresh(); ProbMoeUp P; P.A = WSP(unsigned char, Ap, WS_H2); P.Bt = WSP(unsigned char, Ap, WS_WGU); P.idx = WSP(int, Ap, WS_IDX); P.K = DM; P.ord.init_group(2 * FF / 256, gm);
          EpiSwiglu E{WSP(unsigned char, Ap, WS_HID)}; pg8::gemm_phase<ProbMoeUp, EpiSwiglu, true>(F.lds, F.tid, P, E); }
        block_handoff(F);
        { KArgs* Ap = kargs_fresh(); ProbMoeDown P; P.A = WSP(unsigned char, Ap, WS_HID); P.Bt = WSP(unsigned char, Ap, WS_WDN); P.K = FF; P.ord.init_group(DM / 256, gm);
          EpiDown E{WSP(bf16_t, Ap, WS_MOUT)}; pg8::gemm_phase<ProbMoeDown, EpiDown, true>(F.lds, F.tid, P, E); }
        frame_refresh(F);
    }
    LBAR();
    p10_final(F);
#undef LBAR
}

extern "C" void kernel_launch(void* const* d_in, const int* in_sizes, int n_in, void* d_out, int out_size, void* d_ws, size_t ws_size, hipStream_t stream) {
    static int grid = 0;
    if (grid == 0) {
        if (n_in != 21 || in_sizes[0] != MTOK * DM || out_size != MTOK * DM || ws_size < WS_END) { fprintf(stderr, "kernel_launch: unexpected shapes (n_in %d, in0 %d, out %d, ws %zu)\n", n_in, n_in > 0 ? in_sizes[0] : -1, out_size, ws_size); grid = -1; return; }
        int dev = 0, cus = 0, per_cu = 0;
        if (hipGetDevice(&dev) != hipSuccess || hipDeviceGetAttribute(&cus, hipDeviceAttributeMultiprocessorCount, dev) != hipSuccess) { grid = -1; return; }
        if (hipFuncSetAttribute((const void*)hymba_fwd, hipFuncAttributeMaxDynamicSharedMemorySize, LDS_BYTES) != hipSuccess) { fprintf(stderr, "kernel_launch: hipFuncSetAttribute failed\n"); grid = -1; return; }
        if (hipOccupancyMaxActiveBlocksPerMultiprocessor(&per_cu, (const void*)hymba_fwd, NTHR, LDS_BYTES) != hipSuccess || per_cu < 1) { fprintf(stderr, "kernel_launch: occupancy query says %d\n", per_cu); per_cu = 1; }
        (void)hipGetLastError();
        grid = cus * (per_cu < 1 ? 1 : 1);
    }
    if (grid < 0) return;
    Args a{};
    const float** ap = (const float**)&a;
    for (int i = 0; i < 21; ++i) ap[i] = (const float*)d_in[i];
    a.out = (float*)d_out; a.ws = (unsigned char*)d_ws;
#if BARRIER_KIND == 1
    if (hipMemsetAsync((char*)d_ws + WS_CTL, 0, 65536, stream) != hipSuccess) { fprintf(stderr, "kernel_launch: memset failed\n"); return; }
#endif
    void* kargs[] = {&a};
    const hipError_t le = hipLaunchCooperativeKernel((const void*)hymba_fwd, dim3(grid), dim3(NTHR), kargs, LDS_BYTES, stream);
    if (le != hipSuccess) fprintf(stderr, "kernel_launch: cooperative launch failed: %s (grid %d)\n", hipGetErrorString(le), grid);
}
```

```cpp
#include <hip/hip_runtime.h>
#include <hip/hip_cooperative_groups.h>
#include <cstdio>
namespace cg = cooperative_groups;

#ifndef BARRIER_KIND
#define BARRIER_KIND 1
#endif
#ifndef N_LANES
#define N_LANES 2
#endif

#define LAS __attribute__((address_space(3)))
#define DI __device__ __forceinline__
typedef unsigned short bf16_t;
typedef short bf16x8 __attribute__((ext_vector_type(8)));
typedef float f32x4 __attribute__((ext_vector_type(4)));
typedef float f32x2 __attribute__((ext_vector_type(2)));
typedef unsigned u32x4 __attribute__((ext_vector_type(4)));
typedef unsigned u32x2 __attribute__((ext_vector_type(2)));

constexpr int NB = 16, SEQ = 4096, DM = 1024, MTOK = NB * SEQ, CTXL = 256, MCTX = NB * CTXL;
constexpr int GW = 64;
constexpr int CWID = 512, HWID = 512, HD = 128, NH = 4, CK = 31, CPAD = 15;
constexpr int NE = 16, FF = 1024, CAP = 512, NGRP = NB * NE, MROWS = NGRP * CAP;
constexpr int OFF_A = 0, OFF_B = 512, OFF_Q = 1024, OFF_I = 1536, OFF_FF = 2048, OFF_FB = 2560, OFF_G = 3072, INC = 3584;
constexpr int PCW = 1536;
constexpr int MODW = 6 * DM;
constexpr float EPS = 1e-6f;

constexpr size_t MiB = 1u << 20;
constexpr size_t WS_CTL = 0;
constexpr size_t WS_MOD = 1 * MiB;
constexpr size_t WS_LB = WS_MOD + 512 * 1024;
constexpr size_t WS_PROBS = 2 * MiB;
constexpr size_t WS_IDX = 6 * MiB;
constexpr size_t WS_GATE = 6 * MiB + 512 * 1024;
constexpr size_t WS_SEL = 7 * MiB;
constexpr size_t WS_WIN = 16 * MiB;
constexpr size_t WS_WOUT = 23 * MiB;
constexpr size_t WS_WGU = 25 * MiB;
constexpr size_t WS_WDN = 89 * MiB;
constexpr size_t WS_H = 128 * MiB;
constexpr size_t WS_PL = 264 * MiB;
constexpr size_t PLANE = 8 * MiB;
constexpr size_t HREG = 40 * PLANE;
DI size_t fix_pl(int h) { return (size_t)h * (HREG - PLANE); }
DI size_t fix_h2(int h) { return (size_t)h * (HREG - 32 * MiB); }
DI size_t fix_mix(int h) { return (size_t)h * (HREG - 64 * MiB); }
DI size_t fix_hid(int h) { return (size_t)h * (HREG - 64 * MiB); }
DI size_t fix_mout(int h) { return (size_t)h * (HREG - 128 * MiB); }
constexpr int PL_U = 0, PL_Q = 4, PL_I = 8, PL_FF = 12, PL_FB = 16, PL_G = 20, PL_QB = 24, PL_OF = 28, PL_OB = 32, PL_CPRE = 36, NPLANES = 40;
constexpr size_t WS_PCTX = 904 * MiB;
constexpr size_t CPLANE = 1 * MiB;
constexpr size_t WS_EARR = 916 * MiB;
constexpr size_t WS_H2 = WS_PL;
constexpr size_t WS_HID = WS_PL + 12 * PLANE;
constexpr size_t WS_MOUT = WS_PL + 20 * PLANE;
constexpr size_t WS_MIX = WS_PL + 4 * PLANE;
constexpr size_t WS_END = 922 * MiB;
static_assert(WS_PL + 2 * HREG <= WS_PCTX, "plane regions");
constexpr int NCHK = 4 + 64;

constexpr int LDS_BYTES = 147456, MISC_OFF = 147456 - 128;
constexpr int NTHR = 512, NWAVES = 8;

struct Args {
    const float *x, *c, *ctx, *c_ctx, *ada_w, *ada_b, *norm1_g, *w_in, *taps, *conv_bias, *ln_g, *ln_b, *lb_logits, *hgrn_g, *w_out, *norm2_g, *router, *w_gate, *w_up, *w_down, *final_g;
    float* out; unsigned char* ws; int ph_lo, ph_hi;
};

DI float bf2f(bf16_t b) { return __uint_as_float(((unsigned)b) << 16); }
DI unsigned f2bf(float f) { unsigned u = __float_as_uint(f); return (u + 0x7fffu + ((u >> 16) & 1u)) >> 16; }
DI unsigned pk2(float lo, float hi) { return f2bf(lo) | (f2bf(hi) << 16); }
DI float bflo(unsigned w) { return __uint_as_float(w << 16); }
DI float bfhi(unsigned w) { return __uint_as_float(w & 0xffff0000u); }
DI float sigmoidf_(float x) { return __builtin_amdgcn_rcpf(1.0f + __expf(-x)); }
DI float siluf_(float x) { return x * __builtin_amdgcn_rcpf(1.0f + __expf(-x)); }
DI float wave_sum(float v) {
#pragma unroll
    for (int o = 1; o < 64; o <<= 1) v += __shfl_xor(v, o);
    return v;
}
typedef float f32x2_t __attribute__((ext_vector_type(2))); typedef __bf16 bf16x2_t __attribute__((ext_vector_type(2)));
DI unsigned cvtpk_s(float lo, float hi) { f32x2_t v = {lo, hi}; bf16x2_t b = __builtin_convertvector(v, bf16x2_t); return __builtin_bit_cast(unsigned, b); }

namespace pg8 {
constexpr int BM = 256, BK = 64, HALF = 128, HTB = HALF * BK * 2, STAGE_BYTES = 8 * HTB, NXCD = 8, WGM = 8;
DI int lds_byte(int r, int c) { const int st = (r >> 4) * 2 + (c >> 5), rr = r & 15, cc = c & 31, ob = rr * 64 + cc * 2; return st * 1024 + (ob ^ (((ob >> 9) & 1) << 5)); }
DI void stage_rc(int b, int& R, int& C) { const int st = b / 1024, sb = b % 1024, swz = sb ^ (((sb >> 9) & 1) << 5); R = (st >> 1) * 16 + swz / 64; C = (st & 1) * 32 + (swz % 64) / 2; }
DI int perm32(int rho) { const int n = rho >> 4, i = rho & 15; return 8 * (i >> 2) + 4 * n + (i & 3); }
struct Unit { int pm, pn; };
typedef int v8i __attribute__((ext_vector_type(8))); typedef int v4i __attribute__((ext_vector_type(4)));
DI void mfma_fp8(f32x4& acc, const v8i& a, const v8i& b, int sc) { asm volatile("v_mfma_scale_f32_16x16x128_f8f6f4 %0, %1, %2, %0, %3, %3 op_sel_hi:[0,0,0]" : "+v"(acc) : "v"(a), "v"(b), "v"(sc)); }
DI v8i cat8(bf16x8 a, bf16x8 b) { return __builtin_shufflevector(__builtin_bit_cast(v4i, a), __builtin_bit_cast(v4i, b), 0, 1, 2, 3, 4, 5, 6, 7); }

struct TileOrder {
    int nM, nN, nwg, G, c, pm0, moe_b0, gm; bool own;
    DI void init(int nM_, int nN_, int G_, int c_, int pm0_ = 0, int moe_b0_ = -1) { nM = nM_; nN = nN_; nwg = nM * nN; G = G_; c = c_; pm0 = pm0_; moe_b0 = moe_b0_; own = false; gm = -1; }
    DI void init_own(int nM_, int nN_, int G_, int c_, int pm0_) { init(nM_, nN_, G_, c_, pm0_); own = true; }
    DI void init_group(int nN_, int gm_) { init(2, nN_, 1, 0); gm = gm_; }
    DI bool next(int i, Unit& u) const {
        if (gm >= 0) { if (i >= 2 * nN) return false; const int r = i >= nN ? 1 : 0; u.pn = i - r * nN; u.pm = gm + r; return true; }
        if (own) { const int r = i / nN, pml = c + r * G; if (pml >= nM) return false; u.pn = i - r * nN; u.pm = pml + pm0; return true; }
        const long L = (long)i * G + c; if (L >= nwg) return false;
        int wgid = (int)L; { const int q = nwg / NXCD, r = nwg % NXCD, xcd = wgid % NXCD, off = wgid / NXCD; wgid = (xcd < r ? xcd * (q + 1) : r * (q + 1) + (xcd - r) * q) + off; }
        const int nig = WGM * nN, gid = wgid / nig, fm = gid * WGM, gsz = (nM - fm) < WGM ? (nM - fm) : WGM;
        const int pml = fm + ((wgid % nig) % gsz); u.pn = (wgid % nig) / gsz;
        u.pm = moe_b0 >= 0 ? ((pml >> 4) * 32 + (moe_b0 + ((pml >> 1) & 7)) * 2 + (pml & 1)) : pml + pm0; return true;
    }
};

template <class Prob, class Epi, bool ALIGN_EPI>
DI void gemm_phase(LAS unsigned char* lds, const int tid, const Prob& P, const Epi& E) {
    constexpr bool GATHER = Prob::GATHER, FP8 = Prob::FP8;
    const int wid = __builtin_amdgcn_readfirstlane(tid >> 6), lane = tid & 63, wr = wid >> 2, wc = wid & 3, fr = lane & 15, fq = lane >> 4;
    const int KB = P.K * (FP8 ? 1 : 2), nt = KB / 128;
    unsigned voffA[2], voffB[2];
#pragma unroll
    for (int i = 0; i < 2; ++i) { int R, C; stage_rc(tid * 16 + i * 8192, R, C); const int Rb = Epi::PERM ? ((R & ~31) + perm32(R & 31)) : R; voffA[i] = (unsigned)(R * KB + C * 2); voffB[i] = (unsigned)(Rb * KB + C * 2); }
    const unsigned kstep = 128u;
    const size_t hstep = (size_t)HALF * KB;
    const unsigned ldsw = (unsigned)wid * 1024u;
    const int aoff = lds_byte(wr * 64 + fr, fq * 8), boff = lds_byte(wc * 32 + fr, fq * 8);
#define PG8_SA(b, h) (((b) * 2 + (h)) * HTB)
#define PG8_SB(b, h) ((4 + (b) * 2 + (h)) * HTB)
#define PG8_STAGE(bufoff, gbase, voff) do { _Pragma("unroll") for (int _i = 0; _i < 2; ++_i) \
        __builtin_amdgcn_global_load_lds((const unsigned*)((const char*)(gbase) + (voff)[_i]), (LAS unsigned*)(lds + (bufoff) + ldsw + _i * 8192), 16, 0, 0); } while (0)
#define PG8_LDA(dst, b, h) do { _Pragma("unroll") for (int m = 0; m < 4; ++m) { if constexpr (FP8) { dst##8[m] = cat8(*(const LAS bf16x8*)(lds + PG8_SA(b, h) + aoff + m * 2048), *(const LAS bf16x8*)(lds + PG8_SA(b, h) + aoff + m * 2048 + 1024)); } \
        else { _Pragma("unroll") for (int k = 0; k < 2; ++k) dst[m][k] = *(const LAS bf16x8*)(lds + PG8_SA(b, h) + aoff + m * 2048 + k * 1024); } } } while (0)
#define PG8_LDB(dst, b, h) do { _Pragma("unroll") for (int n = 0; n < 2; ++n) { if constexpr (FP8) { dst##8[n] = cat8(*(const LAS bf16x8*)(lds + PG8_SB(b, h) + boff + n * 2048), *(const LAS bf16x8*)(lds + PG8_SB(b, h) + boff + n * 2048 + 1024)); } \
        else { _Pragma("unroll") for (int k = 0; k < 2; ++k) dst[n][k] = *(const LAS bf16x8*)(lds + PG8_SB(b, h) + boff + n * 2048 + k * 1024); } } } while (0)
#define PG8_MMA(ai, bj, At, Bt) do { if constexpr (!FP8) __builtin_amdgcn_s_setprio(1); else asm volatile("s_setprio 1"); _Pragma("unroll") for (int m = 0; m < 4; ++m) _Pragma("unroll") for (int n = 0; n < 2; ++n) { \
        if constexpr (FP8) { mfma_fp8(acc[ai][bj][m][n], Bt##8[n], At##8[m], sc1); } \
        else { _Pragma("unroll") for (int k = 0; k < 2; ++k) acc[ai][bj][m][n] = __builtin_amdgcn_mfma_f32_16x16x32_bf16(Bt[n][k], At[m][k], acc[ai][bj][m][n], 0, 0, 0); } } \
        if constexpr (!FP8) __builtin_amdgcn_s_setprio(0); else asm volatile("s_setprio 0"); } while (0)
#define PG8_WAIT_V(n) asm volatile("s_waitcnt vmcnt(" #n ")" ::: "memory")
#define PG8_WAIT_L(n) asm volatile("s_waitcnt lgkmcnt(" #n ")" ::: "memory")
#define PG8_BAR __builtin_amdgcn_s_barrier()
#define PG8_SCHED __builtin_amdgcn_sched_barrier(0)
#define PG8_STA(buf, base, V, h) do { if constexpr (GATHER) { PG8_STAGE_G(buf, base, V, h); } else { PG8_STAGE(buf, base, V); } } while (0)
#define PG8_KBODY(A1, VA1, A2H0, V2, A2H1, A3H0, B2, B3) do { \
            PG8_LDB(B0, 0, 0); PG8_LDB(B1, 0, 1); PG8_SCHED; PG8_LDA(At, 0, 0); PG8_STA(PG8_SA(1, 1), A1, VA1, 1); \
            PG8_WAIT_V(8); PG8_WAIT_L(0); PG8_BAR; PG8_MMA(0, 0, At, B0); PG8_MMA(0, 1, At, B1); PG8_BAR; PG8_SCHED; \
            PG8_LDA(At, 0, 1); PG8_STAGE(PG8_SB(0, 0), B2, voffB); PG8_STAGE(PG8_SB(0, 1), (B2) + hstep, voffB); PG8_STA(PG8_SA(0, 0), A2H0, V2, 0); \
            PG8_WAIT_V(8); PG8_WAIT_L(0); PG8_BAR; PG8_MMA(1, 0, At, B0); PG8_MMA(1, 1, At, B1); PG8_BAR; PG8_SCHED; \
            PG8_LDB(B0, 1, 0); PG8_LDB(B1, 1, 1); PG8_SCHED; PG8_LDA(At, 1, 0); PG8_STA(PG8_SA(0, 1), A2H1, V2, 1); \
            PG8_WAIT_V(8); PG8_WAIT_L(0); PG8_BAR; PG8_MMA(0, 0, At, B0); PG8_MMA(0, 1, At, B1); PG8_BAR; PG8_SCHED; \
            PG8_LDA(At, 1, 1); PG8_STAGE(PG8_SB(1, 0), B3, voffB); PG8_STAGE(PG8_SB(1, 1), (B3) + hstep, voffB); PG8_STA(PG8_SA(1, 0), A3H0, V2, 0); \
            PG8_WAIT_V(8); PG8_WAIT_L(0); PG8_BAR; PG8_MMA(1, 0, At, B0); PG8_MMA(1, 1, At, B1); PG8_BAR; PG8_SCHED; } while (0)
    Unit cur, nxt; int ui = 0;
    if (!P.next(0, cur)) return;
    f32x4 acc[2][2][4][2];
#pragma unroll
    for (int a = 0; a < 2; ++a)
#pragma unroll
        for (int b = 0; b < 2; ++b)
#pragma unroll
            for (int m = 0; m < 4; ++m)
#pragma unroll
                for (int n = 0; n < 2; ++n) acc[a][b][m][n] = (f32x4){0.f, 0.f, 0.f, 0.f};
    int sc1 = 0x7f7f7f7f; asm volatile("" : "+v"(sc1));
    bf16x8 At[4][2], B0[2][2], B1[2][2]; v8i At8[4], B08[2], B18[2];
    unsigned pa[2], c2[2];
    const char* cA;
    if constexpr (GATHER) { P.a_rows(cur, tid, pa); cA = (const char*)P.a_base(cur);
#pragma unroll
        for (int i = 0; i < 2; ++i) { int R, C; stage_rc(tid * 16 + i * 8192, R, C); c2[i] = (unsigned)(C * 2); } }
    else { cA = (const char*)P.a_tile(cur); }
#define PG8_STAGE_G(bufoff, gbase, pk, h) do { _Pragma("unroll") for (int _i = 0; _i < 2; ++_i) { const unsigned _off = (((pk)[_i] >> (16 * (h))) & 0xffffu) * (unsigned)KB + c2[_i]; \
        __builtin_amdgcn_global_load_lds((const unsigned*)((const char*)(gbase) + _off), (LAS unsigned*)(lds + (bufoff) + ldsw + _i * 8192), 16, 0, 0); } } while (0)
    const char* cB = (const char*)P.b_base(cur);
    PG8_STAGE(PG8_SB(0, 0), cB, voffB); PG8_STAGE(PG8_SB(0, 1), cB + hstep, voffB);
    if constexpr (GATHER) { PG8_STAGE_G(PG8_SA(0, 0), cA, pa, 0); PG8_STAGE_G(PG8_SA(0, 1), cA, pa, 1); } else { PG8_STAGE(PG8_SA(0, 0), cA, voffA); PG8_STAGE(PG8_SA(0, 1), cA + hstep, voffA); }
    if (wr == 1) PG8_BAR;
    PG8_WAIT_V(2); PG8_BAR;
    PG8_STAGE(PG8_SB(1, 0), cB + kstep, voffB);
    if constexpr (GATHER) { PG8_STAGE_G(PG8_SA(1, 0), cA + kstep, pa, 0); } else { PG8_STAGE(PG8_SA(1, 0), cA + kstep, voffA); }
    PG8_STAGE(PG8_SB(1, 1), cB + hstep + kstep, voffB);
    PG8_WAIT_V(6); PG8_BAR;
    for (;;) {
        const bool has_next = P.next(ui + 1, nxt);
        const char* nB = has_next ? (const char*)P.b_base(nxt) : cB;
        if constexpr (GATHER) {
            unsigned pn[2]; const char* nA = has_next ? (const char*)P.a_base(nxt) : cA;
            if (has_next) P.a_rows(nxt, tid, pn); else { pn[0] = pa[0]; pn[1] = pa[1]; }
            for (int t = 0; t < nt; t += 2) {
                const bool last = (t == nt - 2);
                const char* a1 = cA + (size_t)(t + 1) * kstep;
                const char* a2 = last ? nA : cA + (size_t)(t + 2) * kstep; const char* b2 = last ? nB : cB + (size_t)(t + 2) * kstep;
                unsigned p2[2]; p2[0] = last ? pn[0] : pa[0]; p2[1] = last ? pn[1] : pa[1];
                PG8_KBODY(a1, pa, a2, p2, a2, a2 + kstep, b2, b2 + kstep); }
            pa[0] = pn[0]; pa[1] = pn[1]; cA = nA;
        } else {
            const char* nA = has_next ? (const char*)P.a_tile(nxt) : cA;
            for (int t = 0; t < nt; t += 2) {
                const bool last = (t == nt - 2);
                const char* a1 = cA + hstep + (size_t)(t + 1) * kstep;
                const char* a2 = last ? nA : cA + (size_t)(t + 2) * kstep; const char* b2 = last ? nB : cB + (size_t)(t + 2) * kstep;
                PG8_KBODY(a1, voffA, a2, voffA, a2 + hstep, a2 + kstep, b2, b2 + kstep); }
            cA = nA;
        }
        if constexpr (ALIGN_EPI) { if (wr == 0) PG8_BAR; }
        if constexpr (FP8) asm volatile("s_nop 15\n\ts_nop 15" ::: "memory");
        E(acc, cur, wr, wc, fr, fq);
        if (!has_next) break;
#pragma unroll
        for (int a = 0; a < 2; ++a)
#pragma unroll
            for (int b = 0; b < 2; ++b)
#pragma unroll
                for (int m = 0; m < 4; ++m)
#pragma unroll
                    for (int n = 0; n < 2; ++n) acc[a][b][m][n] = (f32x4){0.f, 0.f, 0.f, 0.f};
        cur = nxt; cB = nB; ++ui;
        if constexpr (ALIGN_EPI) { if (wr == 1) PG8_BAR; }
    }
    PG8_WAIT_V(0);
    if constexpr (!ALIGN_EPI) { if (wr == 0) PG8_BAR; }
    PG8_BAR;
#undef PG8_KBODY
#undef PG8_STA
#undef PG8_STAGE_G
#undef PG8_SA
#undef PG8_SB
#undef PG8_STAGE
#undef PG8_LDA
#undef PG8_LDB
#undef PG8_MMA
#undef PG8_WAIT_V
#undef PG8_WAIT_L
#undef PG8_BAR
#undef PG8_SCHED
}
}
using pg8::Unit;

struct ProbDense {
    static constexpr bool GATHER = false, FP8 = false;
    const bf16_t* A; const bf16_t* Bt; int K; pg8::TileOrder ord;
    DI bool next(int i, Unit& u) const { return ord.next(i, u); }
    DI const void* a_tile(const Unit& u) const { return A + (size_t)u.pm * 256 * K; }
    DI const void* b_base(const Unit& u) const { return Bt + (size_t)u.pn * 256 * K; }
};
DI void moe_unit(int pmv, int& g, int& half, int& e) { e = pmv >> 5; const int b = (pmv >> 1) & 15; half = pmv & 1; g = b * NE + e; }
struct ProbMoeUp {
    static constexpr bool GATHER = true, FP8 = true;
    const unsigned char* A; const unsigned char* Bt; const int* idx; int K; pg8::TileOrder ord;
    DI bool next(int i, Unit& u) const { return ord.next(i, u); }
    DI const void* a_base(const Unit& u) const { return A + fix_h2(((u.pm >> 1) & 15) >> 3); }
    DI const void* b_base(const Unit& u) const { int g, half, e; moe_unit(u.pm, g, half, e); return Bt + ((size_t)e * 2048 + (size_t)u.pn * 256) * K; }
    DI void a_rows(const Unit& u, int tid, unsigned (&pk)[2]) const {
        int g, half, e; moe_unit(u.pm, g, half, e); const int b = g >> 4;
#pragma unroll
        for (int i = 0; i < 2; ++i) { int R, C; pg8::stage_rc(tid * 16 + i * 8192, R, C);
            const int t0 = idx[g * CAP + half * 256 + R], t1 = idx[g * CAP + half * 256 + 128 + R]; pk[i] = (unsigned)(b * SEQ + t0) | ((unsigned)(b * SEQ + t1) << 16); }
    }
};
struct ProbMoeDown {
    static constexpr bool GATHER = false, FP8 = true;
    const unsigned char* A; const unsigned char* Bt; int K; pg8::TileOrder ord;
    DI bool next(int i, Unit& u) const { return ord.next(i, u); }
    DI const void* a_tile(const Unit& u) const { int g, half, e; moe_unit(u.pm, g, half, e); return A + fix_hid(g >> 7) + ((size_t)g * CAP + half * 256) * K; }
    DI const void* b_base(const Unit& u) const { int g, half, e; moe_unit(u.pm, g, half, e); return Bt + ((size_t)e * 1024 + (size_t)u.pn * 256) * K; }
};

DI void store8(bf16_t* p, const f32x4 v0, const f32x4 v1) { u32x4 w; w.x = cvtpk_s(v0[0], v0[1]); w.y = cvtpk_s(v0[2], v0[3]); w.z = cvtpk_s(v1[0], v1[1]); w.w = cvtpk_s(v1[2], v1[3]); *(u32x4*)p = w; }
struct EpiPlanes {
    static constexpr bool PERM = true;
    bf16_t* pl0;
    DI void operator()(const f32x4 (&acc)[2][2][4][2], const Unit& u, int wr, int wc, int fr, int fq) const {
        const int row0 = u.pm * 256 + wr * 64 + fr, col0 = wc * 32 + 8 * fq;
        bf16_t* const pl = pl0 + fix_pl(u.pm >> 7) / 2;
        if (u.pn < 4) {
            bf16_t* base = pl + (size_t)u.pn * (PLANE / 2) + col0;
#pragma unroll
            for (int ai = 0; ai < 2; ++ai)
#pragma unroll
                for (int m = 0; m < 4; ++m) { f32x4 r0, r1;
#pragma unroll
                    for (int j = 0; j < 4; ++j) { r0[j] = acc[ai][0][m][0][j] * sigmoidf_(acc[ai][1][m][0][j]); r1[j] = acc[ai][0][m][1][j] * sigmoidf_(acc[ai][1][m][1][j]); }
                    store8(base + (size_t)(row0 + ai * 128 + m * 16) * 128, r0, r1); }
        } else {
            bf16_t* base = pl + (size_t)(2 * u.pn - 4) * (PLANE / 2) + col0;
#pragma unroll
            for (int ai = 0; ai < 2; ++ai)
#pragma unroll
                for (int m = 0; m < 4; ++m)
#pragma unroll
                    for (int bj = 0; bj < 2; ++bj) store8(base + (size_t)bj * (PLANE / 2) + (size_t)(row0 + ai * 128 + m * 16) * 128, acc[ai][bj][m][0], acc[ai][bj][m][1]);
        }
    }
};
struct EpiCtxPlanes {
    static constexpr bool PERM = true;
    bf16_t* pl;
    DI void operator()(const f32x4 (&acc)[2][2][4][2], const Unit& u, int wr, int wc, int fr, int fq) const {
        const int row0 = u.pm * 256 + wr * 64 + fr, col0 = wc * 32 + 8 * fq;
        bf16_t* base = pl + (size_t)(2 * u.pn) * (CPLANE / 2) + col0;
#pragma unroll
        for (int ai = 0; ai < 2; ++ai)
#pragma unroll
            for (int m = 0; m < 4; ++m)
#pragma unroll
                for (int bj = 0; bj < 2; ++bj) store8(base + (size_t)bj * (CPLANE / 2) + (size_t)(row0 + ai * 128 + m * 16) * 128, acc[ai][bj][m][0], acc[ai][bj][m][1]);
    }
};
struct EpiX1 {
    static constexpr bool PERM = true;
    bf16_t* O; const float* x; const float* mod;
    DI void operator()(const f32x4 (&acc)[2][2][4][2], const Unit& u, int wr, int wc, int fr, int fq) const {
        const int row0 = u.pm * 256 + wr * 64 + fr, col0 = u.pn * 256 + wc * 64 + 8 * fq;
        bf16_t* const Oh = O + fix_mix(u.pm >> 7) / 2;
        const float* const g1p = mod + (size_t)(u.pm >> 4) * MODW + 2 * DM + col0;
        f32x4 g1[2][2];
#pragma unroll
        for (int bj = 0; bj < 2; ++bj) { g1[bj][0] = *(const f32x4*)(g1p + bj * 32); g1[bj][1] = *(const f32x4*)(g1p + bj * 32 + 4); }
#pragma unroll
        for (int ai = 0; ai < 2; ++ai) {
            f32x4 xv[4][2][2];
#pragma unroll
            for (int m = 0; m < 4; ++m)
#pragma unroll
                for (int bj = 0; bj < 2; ++bj) { const float* xp = x + (size_t)(row0 + ai * 128 + m * 16) * DM + col0 + bj * 32; xv[m][bj][0] = *(const f32x4*)xp; xv[m][bj][1] = *(const f32x4*)(xp + 4); }
#pragma unroll
            for (int m = 0; m < 4; ++m)
#pragma unroll
                for (int bj = 0; bj < 2; ++bj) store8(Oh + (size_t)(row0 + ai * 128 + m * 16) * DM + col0 + bj * 32, xv[m][bj][0] + g1[bj][0] * acc[ai][bj][m][0], xv[m][bj][1] + g1[bj][1] * acc[ai][bj][m][1]);
        }
    }
};
constexpr float WSCALE = 32.0f, WINV = 1.0f / 32.0f;
DI unsigned pk4_fp8(float a, float b, float c, float d) { unsigned w = 0; w = __builtin_amdgcn_cvt_pk_fp8_f32(a, b, w, false); w = __builtin_amdgcn_cvt_pk_fp8_f32(c, d, w, true); return w; }
struct EpiSwiglu {
    static constexpr bool PERM = true;
    unsigned char* hid;
    DI void operator()(const f32x4 (&acc)[2][2][4][2], const Unit& u, int wr, int wc, int fr, int fq) const {
        int g, half, e; moe_unit(u.pm, g, half, e);
        const int row0 = g * CAP + half * 256 + wr * 64 + fr, col0 = u.pn * 128 + wc * 32 + 8 * fq;
#pragma unroll
        for (int ai = 0; ai < 2; ++ai)
#pragma unroll
            for (int m = 0; m < 4; ++m) { unsigned char* rowp = hid + fix_hid(g >> 7) + (size_t)(row0 + ai * 128 + m * 16) * FF + col0;
                float r[8];
#pragma unroll
                for (int n = 0; n < 2; ++n)
#pragma unroll
                    for (int j = 0; j < 4; ++j) { const float gt = acc[ai][0][m][n][j] * WINV, up = acc[ai][1][m][n][j] * WINV; r[n * 4 + j] = siluf_(gt) * up; }
                u32x2 w; w.x = pk4_fp8(r[0], r[1], r[2], r[3]); w.y = pk4_fp8(r[4], r[5], r[6], r[7]);
                *(u32x2*)rowp = w; }
    }
};
struct EpiDown {
    static constexpr bool PERM = true;
    bf16_t* O;
    DI void operator()(const f32x4 (&acc)[2][2][4][2], const Unit& u, int wr, int wc, int fr, int fq) const {
        int g, half, e; moe_unit(u.pm, g, half, e);
        const int row0 = g * CAP + half * 256 + wr * 64 + fr, col0 = u.pn * 256 + wc * 64 + 8 * fq;
#pragma unroll
        for (int ai = 0; ai < 2; ++ai)
#pragma unroll
            for (int m = 0; m < 4; ++m) { bf16_t* rowp = O + fix_mout(g >> 7) / 2 + (size_t)(row0 + ai * 128 + m * 16) * DM + col0;
#pragma unroll
                for (int bj = 0; bj < 2; ++bj) store8(rowp + bj * 32, acc[ai][bj][m][0] * WINV, acc[ai][bj][m][1] * WINV); }
    }
};

#define XB_TMO      128
#define XB_XCNT(j)  (256  + 64 * (j))
#define XB_XSUB(j)  (1280 + 64 * (j))
#define XB_XGEN(j)  (2304 + 64 * (j))
#define XB_TOP      3328
#define XB_TOPGEN   3392
#define XCD_BAR_WORDS 3456
#define XB_SPIN_CAP (1u << 18)
DI unsigned xb_ld(unsigned* p)              { return __hip_atomic_load(p, __ATOMIC_RELAXED, __HIP_MEMORY_SCOPE_AGENT); }
DI unsigned xb_add(unsigned* p, unsigned v) { return __hip_atomic_fetch_add(p, v, __ATOMIC_RELAXED, __HIP_MEMORY_SCOPE_AGENT); }
DI unsigned xb_xcc_id() { return (unsigned)__builtin_amdgcn_s_getreg((3 << 11) | 20) & 0xFu; }
#define XB_SPIN(cond, bar) do { unsigned _sp = 0; while (cond) { __builtin_amdgcn_s_sleep(1); \
    if ((++_sp & 255u) == 0u) { if (xb_ld(&(bar)[XB_TMO])) break; if (_sp > XB_SPIN_CAP) { atomicAdd(&(bar)[XB_TMO], 1u); break; } } } } while (0)
struct XcdBarrier { unsigned* bar; unsigned x; volatile LAS unsigned* st; unsigned nwg; };
DI XcdBarrier xcd_barrier_post(unsigned* bar, volatile LAS unsigned* st, bool leader, unsigned nwg) {
    XcdBarrier b; b.bar = bar; b.x = xb_xcc_id(); b.st = st; b.nwg = nwg;
    if (leader) (void)xb_add(&bar[XB_XCNT(b.x)], 1u);
    return b;
}
DI void xcd_barrier_complete(unsigned* bar, unsigned x, unsigned& nloc, unsigned& nx, const unsigned G) {
    unsigned sum, cnt, mine, sp = 0u;
    for (;;) {
        sum = 0u; cnt = 0u; mine = 0u;
#pragma unroll
        for (unsigned j = 0; j < 16; ++j) { const unsigned c = xb_ld(&bar[XB_XCNT(j)]); sum += c; cnt += (c > 0u) ? 1u : 0u; mine = (j == x) ? c : mine; }
        if (sum == G) break;
        __builtin_amdgcn_s_sleep(1);
        if ((++sp & 255u) == 0u) { if (xb_ld(&bar[XB_TMO])) break; if (sp > XB_SPIN_CAP) { atomicAdd(&bar[XB_TMO], 1u); break; } }
    }
    nloc = mine > 0u ? mine : 1u; nx = cnt > 0u ? cnt : 1u;
}
DI void xcd_barrier(const XcdBarrier& b, bool leader) {
    asm volatile("s_waitcnt vmcnt(0)" ::: "memory");
    __syncthreads();
    if (leader) {
        unsigned* bar = b.bar;
        __builtin_amdgcn_s_waitcnt(0);
        unsigned nloc = b.st[0], nx = b.st[1];
        if (nloc == 0u) { xcd_barrier_complete(bar, b.x, nloc, nx, b.nwg); b.st[0] = nloc; b.st[1] = nx; }
        const unsigned old = xb_add(&bar[XB_XSUB(b.x)], 1u);
        const unsigned gen = old / nloc;
        if (old + 1u == (gen + 1u) * nloc) {
            __builtin_amdgcn_fence(__ATOMIC_RELEASE, "agent");
            asm volatile("s_waitcnt vmcnt(0)" ::: "memory");
            const unsigned og = xb_add(&bar[XB_TOP], 1u);
            const unsigned tg = og / nx;
            if (og + 1u == (tg + 1u) * nx) xb_add(&bar[XB_TOPGEN], 1u);
            else XB_SPIN(xb_ld(&bar[XB_TOPGEN]) == tg, bar);
            __builtin_amdgcn_fence(__ATOMIC_ACQUIRE, "agent");
            xb_add(&bar[XB_XGEN(b.x)], 1u);
            asm volatile("s_waitcnt vmcnt(0)" ::: "memory");
        } else {
            XB_SPIN(xb_ld(&bar[XB_XGEN(b.x)]) == gen, bar);
            __builtin_amdgcn_fence(__ATOMIC_ACQUIRE, "agent");
            asm volatile("s_waitcnt vmcnt(0)" ::: "memory");
        }
    }
    __syncthreads();
}

struct Frame { LAS unsigned char* lds; int tid, lane, wave, blk, nblk, b0, nb; };
DI void frame_refresh(Frame& F) { int l; asm volatile("v_mbcnt_lo_u32_b32 %0, -1, 0\n\tv_mbcnt_hi_u32_b32 %0, -1, %0" : "=v"(l)); F.lane = l; F.tid = F.wave * 64 + l; }
typedef const Args __attribute__((address_space(4))) KArgs;
DI KArgs* kargs_fresh() { KArgs* p = (KArgs*)__builtin_amdgcn_kernarg_segment_ptr(); asm volatile("" : "+s"(p)); return p; }
#define WSP(T, A, off) ((T*)((A)->ws + (off)))

DI void transpose_item(const float* W, int K, int N, bf16_t* WT, int k0, int n0, int drow0, LAS float* scr, int lane) {
#pragma unroll
    for (int i = 0; i < 32; ++i) { const int kk = 2 * i + (lane >> 5); scr[kk * 33 + (lane & 31)] = W[(size_t)(k0 + kk) * N + n0 + (lane & 31)]; }
    asm volatile("s_waitcnt lgkmcnt(0)" ::: "memory");
    const int c = lane & 7;
#pragma unroll
    for (int j = 0; j < 4; ++j) { const int n = (lane >> 3) + 8 * j; const LAS float* s = scr + (8 * c) * 33 + n;
        u32x4 o; o.x = pk2(s[0 * 33], s[1 * 33]); o.y = pk2(s[2 * 33], s[3 * 33]); o.z = pk2(s[4 * 33], s[5 * 33]); o.w = pk2(s[6 * 33], s[7 * 33]);
        *(u32x4*)(WT + (size_t)(drow0 + n) * K + k0 + 8 * c) = o; }
    asm volatile("s_waitcnt lgkmcnt(0)" ::: "memory");
}
DI void transpose_item_fp8(const float* W, int K, int N, unsigned char* WT, int k0, int n0, int drow0, LAS float* scr, int lane) {
#pragma unroll
    for (int i = 0; i < 32; ++i) { const int kk = 2 * i + (lane >> 5); scr[kk * 33 + (lane & 31)] = W[(size_t)(k0 + kk) * N + n0 + (lane & 31)]; }
    asm volatile("s_waitcnt lgkmcnt(0)" ::: "memory");
    const int c = lane & 7;
#pragma unroll
    for (int j = 0; j < 4; ++j) { const int n = (lane >> 3) + 8 * j; const LAS float* s = scr + (8 * c) * 33 + n;
        u32x2 o; o.x = pk4_fp8(s[0 * 33] * WSCALE, s[1 * 33] * WSCALE, s[2 * 33] * WSCALE, s[3 * 33] * WSCALE); o.y = pk4_fp8(s[4 * 33] * WSCALE, s[5 * 33] * WSCALE, s[6 * 33] * WSCALE, s[7 * 33] * WSCALE);
        *(u32x2*)(WT + (size_t)(drow0 + n) * K + k0 + 8 * c) = o; }
    asm volatile("s_waitcnt lgkmcnt(0)" ::: "memory");
}
template <int PART>
DI void p0_transposes(Frame& F) {
    KArgs* Ap = kargs_fresh(); KArgs& A = *Ap;
    bf16_t* const win = WSP(bf16_t, Ap, WS_WIN); bf16_t* const wout = WSP(bf16_t, Ap, WS_WOUT); unsigned char* const wgu = WSP(unsigned char, Ap, WS_WGU); unsigned char* const wdn = WSP(unsigned char, Ap, WS_WDN);
    LAS float* scr = (LAS float*)(F.lds + F.wave * 16384);
    const int gw = F.blk * NWAVES + F.wave, ngw = F.nblk * NWAVES;
    constexpr int I_IN = 16 * (INC / 32), I_OUT = 16 * 32, I_E = 16 * 32;
    if constexpr (PART == 0) {
        for (int it = gw; it < I_IN + I_OUT; it += ngw) {
            int r = it;
            if (r < I_IN) { const int nb = r % (INC / 32), kb = r / (INC / 32); const int n0 = nb * 32; const int d0 = n0 < 512 ? ((n0 >> 7) * 256 + (n0 & 127)) : (n0 < 1024 ? (((n0 - 512) >> 7) * 256 + 128 + (n0 & 127)) : n0);
                transpose_item(A.w_in, DM, INC, win, kb * 64, n0, d0, scr, F.lane); continue; } r -= I_IN;
            { const int nb = r % 32, kb = r / 32, n0 = nb * 32; transpose_item(A.w_out, DM, DM, wout, kb * 64, n0, (n0 & ~255) + 128 * ((n0 >> 5) & 1) + 32 * ((n0 & 255) >> 6), scr, F.lane); }
        }
    } else {
        for (int r = gw; r < NE * 3 * I_E; r += ngw) {
            const int e = r / (3 * I_E), q = r % (3 * I_E), which = q / I_E, rr = q % I_E, nb = rr % 32, kb = rr / 32, n0 = nb * 32;
            if (which == 0) transpose_item_fp8(A.w_gate + (size_t)e * DM * FF, DM, FF, wgu + (size_t)e * 2048 * DM, kb * 64, n0, (n0 >> 7) * 256 + (n0 & 127), scr, F.lane);
            else if (which == 1) transpose_item_fp8(A.w_up + (size_t)e * DM * FF, DM, FF, wgu + (size_t)e * 2048 * DM, kb * 64, n0, (n0 >> 7) * 256 + 128 + (n0 & 127), scr, F.lane);
            else transpose_item_fp8(A.w_down + (size_t)e * FF * DM, FF, DM, wdn + (size_t)e * DM * FF, kb * 64, n0, (n0 & ~255) + 128 * ((n0 >> 5) & 1) + 32 * ((n0 & 255) >> 6), scr, F.lane);
        }
    }
}
DI void p0_prologue(Frame& F) {
    KArgs* Ap = kargs_fresh(); KArgs& A = *Ap;
    float* const mod = WSP(float, Ap, WS_MOD); float* const lbo = WSP(float, Ap, WS_LB);
    {
        LAS float* sm = (LAS float*)F.lds;
        for (int i = F.tid; i < 17 * DM; i += NTHR) { const int v = i >> 10, k = i & 1023; const float xv = v < 16 ? A.c[v * DM + k] : A.c_ctx[k]; sm[i] = siluf_(xv); }
        __syncthreads();
        LAS float* red = sm + 17 * DM;
        for (int chunk = F.blk; chunk < MODW / 24; chunk += F.nblk) {
            const int col = F.tid % 24, kg = F.tid / 24;
            float acc[17];
#pragma unroll
            for (int v = 0; v < 17; ++v) acc[v] = 0.f;
            if (kg < 21) {
#pragma unroll 7
                for (int k = kg; k < DM; k += 21) { const float w = A.ada_w[(size_t)k * MODW + chunk * 24 + col];
#pragma unroll
                    for (int v = 0; v < 17; ++v) acc[v] += sm[v * DM + k] * w; }
#pragma unroll
                for (int v = 0; v < 17; ++v) red[(kg * 17 + v) * 24 + col] = acc[v];
            }
            __syncthreads();
            if (F.tid < 17 * 24) { const int v = F.tid / 24, cc = F.tid % 24; float s = A.ada_b[chunk * 24 + cc];
                for (int g = 0; g < 21; ++g) s += red[(g * 17 + v) * 24 + cc];
                mod[v * MODW + chunk * 24 + cc] = s; }
            __syncthreads();
        }
    }
    if (F.blk == 0) for (int i = F.tid; i < 2 * HWID; i += NTHR) { const float l0 = A.lb_logits[i], l1 = A.lb_logits[2 * HWID + i]; lbo[i] = 1.0f / (1.0f + __expf(l1 - l0)); }
}

DI void p1_rows(Frame& F, const int grow0, const int NROW, const int gw, const int ngw) {
    KArgs* Ap = kargs_fresh(); KArgs& A = *Ap; const float* const mod = WSP(float, Ap, WS_MOD); bf16_t* const hout = WSP(bf16_t, Ap, WS_H);
    const int lane = F.lane;
#define P1_GROW(r_) (grow0 + (r_))
    f32x4 raw[4][4];
#define P1_LOAD(r0_) do { const int rr_ = P1_GROW(r0_); const float* src_ = rr_ < MTOK ? A.x + (size_t)rr_ * DM : A.ctx + (size_t)(rr_ - MTOK) * DM; \
        _Pragma("unroll") for (int t = 0; t < 4; ++t) _Pragma("unroll") for (int j = 0; j < 4; ++j) raw[t][j] = *(const f32x4*)(src_ + (size_t)t * DM + 4 * lane + 256 * j); } while (0)
    int r0 = gw * 4;
    if (r0 < NROW) P1_LOAD(r0);
    for (; r0 < NROW; r0 += ngw * 4) {
        const int gr0 = P1_GROW(r0);
        const int v = gr0 < MTOK ? (gr0 >> 12) : 16;
        const float* md = mod + (size_t)v * MODW;
        f32x4 xv[4][4]; float ss[4];
#pragma unroll
        for (int t = 0; t < 4; ++t) { ss[t] = 0.f;
#pragma unroll
            for (int j = 0; j < 4; ++j) { xv[t][j] = raw[t][j]; ss[t] += (xv[t][j].x * xv[t][j].x + xv[t][j].y * xv[t][j].y) + (xv[t][j].z * xv[t][j].z + xv[t][j].w * xv[t][j].w); } }
        if (r0 + ngw * 4 < NROW) P1_LOAD(r0 + ngw * 4);
        f32x4 gs[4], sh[4];
#pragma unroll
        for (int j = 0; j < 4; ++j) { const int col = 4 * lane + 256 * j; gs[j] = *(const f32x4*)(A.norm1_g + col) * (*(const f32x4*)(md + DM + col) + 1.0f); sh[j] = *(const f32x4*)(md + col); }
#pragma unroll
        for (int t = 0; t < 4; ++t) { const float rstd = rsqrtf(wave_sum(ss[t]) * (1.0f / DM) + EPS);
            bf16_t* dst = hout + (size_t)(gr0 + t) * DM;
#pragma unroll
            for (int j = 0; j < 4; ++j) { const f32x4 y = xv[t][j] * rstd * gs[j] + sh[j];
                u32x2 w; w.x = cvtpk_s(y.x, y.y); w.y = cvtpk_s(y.z, y.w); *(u32x2*)(dst + 4 * lane + 256 * j) = w; } }
    }
#undef P1_LOAD
#undef P1_GROW
}

template <int P0, int N> DI void conv_out(const f32x2 (&u)[64], const f32x2 (&tp)[CK], const f32x2 bias, bf16_t* dst, const size_t dstride) {
    if constexpr (N == 1) {
        f32x2 s = bias;
#pragma unroll
        for (int k = 0; k < CK; ++k) { const int q = P0 + k - CPAD; if (q >= 0 && q < 64) s += tp[k] * u[q]; }
        *(unsigned*)(dst + (size_t)P0 * dstride) = pk2(s.x, s.y);
    } else { conv_out<P0, N / 2>(u, tp, bias, dst, dstride); conv_out<P0 + N / 2, N - N / 2>(u, tp, bias, dst, dstride); }
}
DI void conv_item(Frame& F, int item) {
    KArgs* Ap = kargs_fresh(); KArgs& A = *Ap;
    const int lane = F.lane;
    const int nline = F.nb * 64, cg2 = item & 1, line = (item >> 1) % nline, axis = (item >> 1) / nline;
    const int b = F.b0 + (line >> 6), l = line & 63;
    const int cgp = axis * 2 + cg2, ch = cgp * 128 + 2 * lane;
    const int tok0 = b * SEQ + (axis == 0 ? l * GW : l), tstride = (axis == 0 ? 1 : GW);
    const bf16_t* const up = WSP(bf16_t, Ap, WS_PL) + fix_pl(b >> 3) / 2 + (size_t)(PL_U + cgp) * (PLANE / 2) + (size_t)tok0 * 128 + 2 * lane;
    bf16_t* const cp = WSP(bf16_t, Ap, WS_PL) + fix_pl(b >> 3) / 2 + (size_t)(PL_CPRE + cgp) * (PLANE / 2) + (size_t)tok0 * 128 + 2 * lane;
    unsigned raw[64];
#pragma unroll
    for (int p = 0; p < 64; ++p) raw[p] = *(const unsigned*)(up + (size_t)p * tstride * 128);
    asm volatile("" ::: "memory");
    f32x2 u[64];
#pragma unroll
    for (int p = 0; p < 64; ++p) { u[p].x = bflo(raw[p]); u[p].y = bfhi(raw[p]); }
    f32x2 tp[CK];
#pragma unroll
    for (int k = 0; k < CK; ++k) tp[k] = *(const f32x2*)(A.taps + k * CWID + ch);
    const f32x2 bias = *(const f32x2*)(A.conv_bias + ch);
    conv_out<0, 64>(u, tp, bias, cp, (size_t)tstride * 128);
}


template <int DIR, bool ISCTX>
DI f32x2 prep_pass(bf16_t* fcol, bf16_t* qsrc, bf16_t* qdst, const f32x2 lbv) {
    const f32x2 om = {1.0f - lbv.x, 1.0f - lbv.y};
    f32x2 G = {1.0f, 1.0f};
#pragma unroll 1
    for (int grp = 0; grp < 4; ++grp) {
        const int t0 = DIR ? grp * 16 : 48 - grp * 16;
        bf16_t* const fp = fcol + t0 * 128; bf16_t* const qp = qsrc + t0 * 128; bf16_t* const qd = qdst + t0 * 128;
        unsigned xw[16], qw[16];
#pragma unroll
        for (int j = 0; j < 16; ++j) { xw[j] = *(const unsigned*)(fp + j * 128); if (!ISCTX) qw[j] = *(const unsigned*)(qp + j * 128); }
#pragma unroll
        for (int i = 0; i < 16; ++i) {
            const int j = DIR ? i : 15 - i;
            f32x2 f; f.x = lbv.x + om.x * sigmoidf_(bflo(xw[j])); f.y = lbv.y + om.y * sigmoidf_(bfhi(xw[j]));
            *(unsigned*)(fp + j * 128) = cvtpk_s((1.0f - f.x) * G.x, (1.0f - f.y) * G.y);
            if (!ISCTX) {
                const float gx = __builtin_amdgcn_rcpf(fmaxf(G.x, 1e-30f)), gy = __builtin_amdgcn_rcpf(fmaxf(G.y, 1e-30f));
                *(unsigned*)(qd + j * 128) = cvtpk_s(bflo(qw[j]) * gx, bfhi(qw[j]) * gy);
            }
            G.x *= f.x; G.y *= f.y;
        }
    }
    return G;
}
DI void prep_item(Frame& F, int item) {
    KArgs* Ap = kargs_fresh(); const float* const lb = WSP(float, Ap, WS_LB); float* const earr = WSP(float, Ap, WS_EARR);
    const int lane = F.lane;
    if (item < F.nb * 64 * NH) {
        const int hh = item & 3, c = (item >> 2) & 63, b = F.b0 + (item >> 8), kc = hh * HD + 2 * lane;
        bf16_t* const t0 = WSP(bf16_t, Ap, WS_PL) + fix_pl(b >> 3) / 2 + (size_t)hh * (PLANE / 2) + (size_t)(b * SEQ + c * 64) * 128 + 2 * lane;
        float* const e0 = earr + ((size_t)((b * NH + hh) * 2) * NCHK + 4) * HD + 2 * lane;
        const f32x2 Gb = prep_pass<1, false>(t0 + (size_t)PL_FB * (PLANE / 2), t0 + (size_t)PL_Q * (PLANE / 2), t0 + (size_t)PL_QB * (PLANE / 2), *(const f32x2*)(lb + HWID + kc));
        *(f32x2*)(e0 + (size_t)(NCHK + (63 - c)) * HD) = Gb;
        const f32x2 Gf = prep_pass<0, false>(t0 + (size_t)PL_FF * (PLANE / 2), t0 + (size_t)PL_Q * (PLANE / 2), t0 + (size_t)PL_Q * (PLANE / 2), *(const f32x2*)(lb + kc));
        *(f32x2*)(e0 + (size_t)c * HD) = Gf;
    } else {
        const int it = item - F.nb * 64 * NH, hh = it & 3, c = (it >> 2) & 3, b = F.b0 + (it >> 4), kc = hh * HD + 2 * lane;
        bf16_t* const t0 = WSP(bf16_t, Ap, WS_PCTX) + (size_t)hh * (CPLANE / 2) + (size_t)(b * CTXL + c * 64) * 128 + 2 * lane;
        float* const e0 = earr + ((size_t)((b * NH + hh) * 2) * NCHK) * HD + 2 * lane;
        const f32x2 Gb = prep_pass<1, true>(t0 + (size_t)8 * (CPLANE / 2), t0, t0, *(const f32x2*)(lb + HWID + kc));
        *(f32x2*)(e0 + (size_t)(NCHK + (3 - c)) * HD) = Gb;
        const f32x2 Gf = prep_pass<0, true>(t0 + (size_t)4 * (CPLANE / 2), t0, t0, *(const f32x2*)(lb + kc));
        *(f32x2*)(e0 + (size_t)c * HD) = Gf;
    }
}

typedef short s16x4 __attribute__((ext_vector_type(4)));
DI s16x4 vtr(LAS const unsigned char* p) { return __builtin_bit_cast(s16x4, __builtin_amdgcn_ds_read_tr16_b64_v4i16((LAS s16x4*)p)); }
constexpr int SC_BUF = 41984, SC_Q = 0, SC_K = 16384, SC_V = 32768, SC_E = 40960, SC_P = 3 * SC_BUF, SC_PSTR = 144, SC_O = SC_P + 64 * SC_PSTR, SC_OSTR = 144;
static_assert(SC_O + 64 * SC_OSTR <= MISC_OFF, "scan LDS map");
DI int swV(int row) { return (((row >> 1) & 1) << 1) | (((row >> 3) & 1) << 2); }
DI int swK(int row) { return (row & 7) << 1; }
DI int swQ(int row) { return row & 15; }
DI int tile_off(int row, int colbyte, int sw) { return row * 256 + ((((colbyte >> 4) ^ sw)) << 4) + (colbyte & 15); }
#define SC_BAR() do { asm volatile("s_waitcnt lgkmcnt(0)" ::: "memory"); __builtin_amdgcn_s_barrier(); asm volatile("" ::: "memory"); } while (0)
DI constexpr int pt_tt(int W, int t) { return W == 0 ? 3 : W == 1 ? (t == 0 ? 3 : 2) : W == 2 ? (t == 0 ? 2 : 1) : 0; }
DI constexpr int pt_st(int W, int t) { return W == 0 ? t : W == 1 ? (t == 0 ? 3 : t - 1) : W == 2 ? (t == 0 ? 2 : t - 1) : 0; }
template <int W> DI void scan_ptiles(LAS unsigned char* lds, const int kb, const int qb, const int pb, const int l15, const int g) {
    constexpr int NT = W == 3 ? 1 : 3;
    int ka[4], qa[4];
#pragma unroll
    for (int ks = 0; ks < 4; ++ks) { ka[ks] = kb ^ (ks << 6); qa[ks] = qb ^ (ks << 6); }
    bf16x8 a[NT][4], bq[NT][4];
#pragma unroll
    for (int t = 0; t < NT; ++t) {
        const bool newq = (t == 0) || pt_tt(W, t) != pt_tt(W, t - 1);
#pragma unroll
        for (int ks = 0; ks < 4; ++ks) {
            a[t][ks] = *(const LAS bf16x8*)(lds + ka[ks] + pt_st(W, t) * 4096);
            if (newq) bq[t][ks] = *(const LAS bf16x8*)(lds + qa[ks] + pt_tt(W, t) * 4096); else bq[t][ks] = bq[t - 1][ks];
        }
    }
    f32x4 acc[NT];
#pragma unroll
    for (int t = 0; t < NT; ++t) acc[t] = (f32x4){0.f, 0.f, 0.f, 0.f};
#pragma unroll
    for (int ks = 0; ks < 4; ++ks)
#pragma unroll
        for (int t = 0; t < NT; ++t) acc[t] = __builtin_amdgcn_mfma_f32_16x16x32_bf16(a[t][ks], bq[t][ks], acc[t], 0, 0, 0);
#pragma unroll
    for (int t = 0; t < NT; ++t) {
        float pv[4];
#pragma unroll
        for (int r = 0; r < 4; ++r) pv[r] = (pt_tt(W, t) != pt_st(W, t) || 4 * g + r <= l15) ? acc[t][r] : 0.f;
        u32x2 pw; pw.x = cvtpk_s(pv[0], pv[1]); pw.y = cvtpk_s(pv[2], pv[3]);
        *(LAS u32x2*)(lds + pb + pt_tt(W, t) * 16 * SC_PSTR + pt_st(W, t) * 32) = pw;
    }
}
DI void scan_item(Frame& F, int item) {
    const int half = item & 1, dir = (item >> 1) & 1, hh = (item >> 2) & 3, b = F.b0 + (item >> 4), stream = (b * NH + hh) * 2 + dir;
    const int tid = F.tid, lane = F.lane, w = F.wave, l15_ = lane & 15, g_ = lane >> 4;
    KArgs* Ap = kargs_fresh();
    LAS unsigned char* const lds = F.lds;
    const unsigned char* const plb = (const unsigned char*)WSP(bf16_t, Ap, WS_PL) + fix_pl(b >> 3) + (size_t)hh * PLANE + (size_t)b * SEQ * 256;
    const unsigned char* const pcb = (const unsigned char*)WSP(bf16_t, Ap, WS_PCTX) + (size_t)hh * CPLANE + (size_t)b * CTXL * 256;
    const unsigned char* const earrb = (const unsigned char*)(WSP(float, Ap, WS_EARR) + (size_t)stream * NCHK * HD);
    bf16_t* const obase = WSP(bf16_t, Ap, WS_PL) + fix_pl(b >> 3) / 2 + (size_t)((dir ? PL_OB : PL_OF) + hh) * (PLANE / 2) + (size_t)b * SEQ * 128 + 64 * half;
    const int vcol = 64 * half + 16 * (w & 3);
    for (int i = tid; i < 64 * SC_PSTR / 4; i += NTHR) *(LAS unsigned*)(lds + SC_P + 4 * i) = 0u;
    f32x4 S[8];
#pragma unroll
    for (int i = 0; i < 8; ++i) S[i] = (f32x4){0.f, 0.f, 0.f, 0.f};
#define SC_DMA(ci_, bi_) do { const int ci__ = (ci_); const int bo_ = (bi_) * SC_BUF; const bool cx = ci__ < 4; const int c64 = (cx ? ci__ : ci__ - 4) * 64; const int pw_ = w - 4; \
        const unsigned char* rb = cx ? pcb : plb; const int nrow = cx ? CTXL : SEQ; \
        const size_t koff = cx ? (size_t)(dir ? 8 : 4) * CPLANE : (size_t)(dir ? PL_FB : PL_FF) * PLANE, voff = cx ? 0 : (size_t)PL_I * PLANE, qoff = cx ? koff : (size_t)(dir ? PL_QB : PL_Q) * PLANE; \
        _Pragma("unroll") for (int pc = 0; pc < 4; ++pc) { const int inst = 4 * pw_ + pc, row = inst * 4 + g_; const int pos = c64 + row, n = dir ? (nrow - 1 - pos) : pos; \
            const unsigned char* rp = rb + (size_t)n * 256; \
            __builtin_amdgcn_global_load_lds((const unsigned*)(rp + qoff + ((l15_ ^ swQ(row)) << 4)), (LAS unsigned*)(lds + bo_ + SC_Q + inst * 1024), 16, 0, 0); \
            __builtin_amdgcn_global_load_lds((const unsigned*)(rp + koff + ((l15_ ^ swK(row)) << 4)), (LAS unsigned*)(lds + bo_ + SC_K + inst * 1024), 16, 0, 0); } \
        _Pragma("unroll") for (int pc = 0; pc < 2; ++pc) { const int vi = 2 * pw_ + pc, row = vi * 8 + (lane >> 3), pos = c64 + row, n = dir ? (nrow - 1 - pos) : pos; \
          __builtin_amdgcn_global_load_lds((const unsigned*)(rb + (size_t)n * 256 + voff + 128 * half + (((lane & 7) ^ swV(row)) << 4)), (LAS unsigned*)(lds + bo_ + SC_V + vi * 1024), 16, 0, 0); } \
        __builtin_amdgcn_global_load_lds((const unsigned*)(earrb + (size_t)ci__ * (HD * 4) + ((lane & 31) << 4)), (LAS unsigned*)(lds + bo_ + SC_E), 16, 0, 0); \
    } while (0)
    if (w >= 4) { SC_DMA(0, 0); SC_DMA(1, 1); }
    int bi = 0;
    for (int ci = 0; ci < NCHK; ++ci) {
        int l15 = l15_, g = g_;
        asm volatile("" : "+v"(l15), "+v"(g));
        if (w >= 4) { if (ci + 2 < NCHK) asm volatile("s_waitcnt vmcnt(11)" ::: "memory"); else asm volatile("s_waitcnt vmcnt(0)" ::: "memory"); }
        SC_BAR();
        if (w >= 4 && ci + 2 < NCHK) { const int b2 = bi == 0 ? 2 : bi - 1; SC_DMA(ci + 2, b2); }
        const bool lat = ci >= 4;
        const int bo = bi * SC_BUF;
        bi = bi == 2 ? 0 : bi + 1;
        if (w < 4 && ci >= 5) {
#pragma unroll
            for (int k = 0; k < 2; ++k) { const int row = (tid >> 3) + 32 * k, ch = tid & 7, pos = (ci - 5) * 64 + row, n = dir ? (SEQ - 1 - pos) : pos;
                *(u32x4*)(obase + (size_t)n * 128 + ch * 8) = *(const LAS u32x4*)(lds + SC_O + row * SC_OSTR + ch * 16); }
        }
        f32x4 OT[4]; bf16x8 vf[2], kq[3][2]; int kvb = 0;
        if (w >= 4) {
            if (lat) {
                const int kb = bo + SC_K + l15 * 256 + ((g ^ ((l15 & 7) << 1)) << 4), qb = bo + SC_Q + l15 * 256 + ((g ^ l15) << 4), pb = SC_P + l15 * SC_PSTR + 8 * g;
                if (w == 4) scan_ptiles<0>(lds, kb, qb, pb, l15, g); else if (w == 5) scan_ptiles<1>(lds, kb, qb, pb, l15, g); else if (w == 6) scan_ptiles<2>(lds, kb, qb, pb, l15, g); else scan_ptiles<3>(lds, kb, qb, pb, l15, g);
            }
        } else {
            const LAS float* Ev = (const LAS float*)(lds + bo + SC_E);
#pragma unroll
            for (int i = 0; i < 8; ++i) S[i] = S[i] * *(const LAS f32x4*)(Ev + 16 * i + 4 * g);
            if (lat) {
                bf16x8 sa[4];
#pragma unroll
                for (int i2 = 0; i2 < 4; ++i2) { u32x4 pk; pk.x = cvtpk_s(S[2 * i2][0], S[2 * i2][1]); pk.y = cvtpk_s(S[2 * i2][2], S[2 * i2][3]); pk.z = cvtpk_s(S[2 * i2 + 1][0], S[2 * i2 + 1][1]); pk.w = cvtpk_s(S[2 * i2 + 1][2], S[2 * i2 + 1][3]);
                    sa[i2] = __builtin_bit_cast(bf16x8, pk); }
#pragma unroll
                for (int j = 0; j < 4; ++j) OT[j] = (f32x4){0.f, 0.f, 0.f, 0.f};
                bf16x8 qf[2][4];
                const int qv = bo + SC_Q + l15 * 256 + ((((g >> 1) ^ l15)) << 4) + 8 * (g & 1);
#define SC_LDQ(dst, i2_) do { const int qlo_ = qv ^ ((4 * (i2_)) << 4), qhi_ = qv ^ ((4 * (i2_) + 2) << 4); _Pragma("unroll") for (int j = 0; j < 4; ++j) { \
                    const u32x2 lo = *(const LAS u32x2*)(lds + qlo_ + j * 4096), hi = *(const LAS u32x2*)(lds + qhi_ + j * 4096); \
                    u32x4 bb; bb.x = lo.x; bb.y = lo.y; bb.z = hi.x; bb.w = hi.y; dst[j] = __builtin_bit_cast(bf16x8, bb); } } while (0)
                SC_LDQ(qf[0], 0);
#pragma unroll
                for (int i2 = 0; i2 < 4; ++i2) {
                    if (i2 + 1 < 4) SC_LDQ(qf[(i2 + 1) & 1], i2 + 1);
#pragma unroll
                    for (int j = 0; j < 4; ++j) OT[j] = __builtin_amdgcn_mfma_f32_16x16x32_bf16(sa[i2], qf[i2 & 1][j], OT[j], 0, 0, 0);
                }
#undef SC_LDQ
            }
            {
                const int qq = l15 >> 2, pp = l15 & 3;
                const int cb = 32 * (w & 3) + 8 * pp;
                const int vv = bo + SC_V + (8 * g + qq) * 128 + ((((cb >> 4) ^ swV(8 * g + qq))) << 4) + (cb & 15);
#pragma unroll
                for (int ks = 0; ks < 2; ++ks) { const s16x4 lo = vtr(lds + vv + ks * 4096), hi = vtr(lds + vv + ks * 4096 + 512);
                    vf[ks] = __builtin_shufflevector(lo, hi, 0, 1, 2, 3, 4, 5, 6, 7); }
                kvb = bo + SC_K + g * 2048 + qq * 256 + ((((pp >> 1) ^ (2 * qq))) << 4) + 8 * (pp & 1);
#define SC_LDK(dst, i_) do { const int k0_ = kvb ^ ((i_) << 5), k1_ = kvb ^ ((((i_) ^ 4)) << 5); _Pragma("unroll") for (int ks = 0; ks < 2; ++ks) { \
                    const s16x4 lo = vtr(lds + k0_ + ks * 8192), hi = vtr(lds + k1_ + ks * 8192 + 1024); \
                    dst[ks] = __builtin_shufflevector(lo, hi, 0, 1, 2, 3, 4, 5, 6, 7); } } while (0)
                SC_LDK(kq[0], 0); SC_LDK(kq[1], 1); SC_LDK(kq[2], 2);
            }
        }
        SC_BAR();
        if (w < 4) {
            if (lat) {
                bf16x8 pb[4][2];
#pragma unroll
                for (int j = 0; j < 4; ++j)
#pragma unroll
                    for (int ks = 0; ks < 2; ++ks) { if (32 * ks > 16 * j + 15) continue; pb[j][ks] = *(const LAS bf16x8*)(lds + SC_P + (16 * j + l15) * SC_PSTR + (32 * ks + 8 * g) * 2); }
#pragma unroll
                for (int j = 0; j < 4; ++j) {
#pragma unroll
                    for (int ks = 0; ks < 2; ++ks) { if (32 * ks > 16 * j + 15) continue; OT[j] = __builtin_amdgcn_mfma_f32_16x16x32_bf16(vf[ks], pb[j][ks], OT[j], 0, 0, 0); }
                    u32x2 ow; ow.x = cvtpk_s(OT[j][0], OT[j][1]); ow.y = cvtpk_s(OT[j][2], OT[j][3]);
                    *(LAS u32x2*)(lds + SC_O + (16 * j + l15) * SC_OSTR + (16 * (w & 3) + 4 * g) * 2) = ow;
                }
            }
            {
                const int qq = l15 >> 2, pp = l15 & 3;
#pragma unroll
                for (int i = 0; i < 8; ++i) {
                    S[i] = __builtin_amdgcn_mfma_f32_16x16x32_bf16(kq[i % 3][0], vf[0], S[i], 0, 0, 0);
                    S[i] = __builtin_amdgcn_mfma_f32_16x16x32_bf16(kq[i % 3][1], vf[1], S[i], 0, 0, 0);
                    if (i + 3 < 8) SC_LDK(kq[i % 3], i + 3);
                }
            }
#undef SC_LDK
        }
    }
    SC_BAR();
    if (w < 4) {
#pragma unroll
        for (int k = 0; k < 2; ++k) { const int row = (tid >> 3) + 32 * k, ch = tid & 7, pos = (NCHK - 5) * 64 + row, n = dir ? (SEQ - 1 - pos) : pos;
            *(u32x4*)(obase + (size_t)n * 128 + ch * 8) = *(const LAS u32x4*)(lds + SC_O + row * SC_OSTR + ch * 16); }
    }
    asm volatile("s_waitcnt vmcnt(0)" ::: "memory");
    SC_BAR();
#undef SC_DMA
}

DI void p4_mixed(Frame& F, const int tbeg, const int tend, const int gw, const int ngw) {
    KArgs* Ap = kargs_fresh(); KArgs& A = *Ap;
    bf16_t* const mixed = WSP(bf16_t, Ap, WS_H);
    const int lane = F.lane;
    const bf16_t* const plq = WSP(bf16_t, Ap, WS_PL) + fix_pl(tbeg >> 15) / 2 + (size_t)(lane >> 4) * (PLANE / 2) + (lane & 15) * 8;
    float lng[8], lnb[8], hg[8];
    { const f32x4 a0 = *(const f32x4*)(A.ln_g + 8 * lane), a1 = *(const f32x4*)(A.ln_g + 8 * lane + 4), b0 = *(const f32x4*)(A.ln_b + 8 * lane), b1 = *(const f32x4*)(A.ln_b + 8 * lane + 4), c0 = *(const f32x4*)(A.hgrn_g + 8 * lane), c1 = *(const f32x4*)(A.hgrn_g + 8 * lane + 4);
#pragma unroll
      for (int j = 0; j < 4; ++j) { lng[j] = a0[j]; lng[4 + j] = a1[j]; lnb[j] = b0[j]; lnb[4 + j] = b1[j]; hg[j] = c0[j]; hg[4 + j] = c1[j]; } }
    u32x4 rc[4], rf[4], rb[4], rg[4];
#define P5_LOAD(t0_) do { _Pragma("unroll") for (int t = 0; t < 4; ++t) { const size_t ro = (size_t)((t0_) + t) * 128; \
        rc[t] = *(const u32x4*)(plq + (size_t)PL_CPRE * (PLANE / 2) + ro); rf[t] = *(const u32x4*)(plq + (size_t)PL_OF * (PLANE / 2) + ro); \
        rb[t] = *(const u32x4*)(plq + (size_t)PL_OB * (PLANE / 2) + ro); rg[t] = *(const u32x4*)(plq + (size_t)PL_G * (PLANE / 2) + ro); } } while (0)
    if (tbeg + gw * 4 < tend) P5_LOAD(tbeg + gw * 4);
    for (int t0 = tbeg + gw * 4; t0 < tend; t0 += ngw * 4) {
        u32x4 cw[4], fw[4], bw[4], gw4[4];
#pragma unroll
        for (int t = 0; t < 4; ++t) { cw[t] = rc[t]; fw[t] = rf[t]; bw[t] = rb[t]; gw4[t] = rg[t]; }
        if (t0 + ngw * 4 < tend) P5_LOAD(t0 + ngw * 4);
#pragma unroll
        for (int t = 0; t < 4; ++t) {
            float cv[8] = {bflo(cw[t].x), bfhi(cw[t].x), bflo(cw[t].y), bfhi(cw[t].y), bflo(cw[t].z), bfhi(cw[t].z), bflo(cw[t].w), bfhi(cw[t].w)};
            float sm = 0.f;
#pragma unroll
            for (int j = 0; j < 8; ++j) sm += cv[j];
            const float mu = wave_sum(sm) * (1.0f / CWID); float q = 0.f;
#pragma unroll
            for (int j = 0; j < 8; ++j) { cv[j] -= mu; q += cv[j] * cv[j]; }
            const float rstd = rsqrtf(wave_sum(q) * (1.0f / CWID) + EPS);
            float r[8];
#pragma unroll
            for (int j = 0; j < 8; ++j) r[j] = siluf_(cv[j] * rstd * lng[j] + lnb[j]);
            u32x4 w; w.x = cvtpk_s(r[0], r[1]); w.y = cvtpk_s(r[2], r[3]); w.z = cvtpk_s(r[4], r[5]); w.w = cvtpk_s(r[6], r[7]);
            *(u32x4*)(mixed + (size_t)(t0 + t) * DM + 8 * lane) = w;
            const float o[8] = {bflo(fw[t].x) + bflo(bw[t].x), bfhi(fw[t].x) + bfhi(bw[t].x), bflo(fw[t].y) + bflo(bw[t].y), bfhi(fw[t].y) + bfhi(bw[t].y), bflo(fw[t].z) + bflo(bw[t].z), bfhi(fw[t].z) + bfhi(bw[t].z), bflo(fw[t].w) + bflo(bw[t].w), bfhi(fw[t].w) + bfhi(bw[t].w)};
            const float gt[8] = {bflo(gw4[t].x), bfhi(gw4[t].x), bflo(gw4[t].y), bfhi(gw4[t].y), bflo(gw4[t].z), bfhi(gw4[t].z), bflo(gw4[t].w), bfhi(gw4[t].w)};
            float ss = 0.f;
#pragma unroll
            for (int j = 0; j < 8; ++j) ss += o[j] * o[j];
            ss += __shfl_xor(ss, 1); ss += __shfl_xor(ss, 2); ss += __shfl_xor(ss, 4); ss += __shfl_xor(ss, 8);
            const float rs = rsqrtf(ss * (1.0f / HD) + EPS);
#pragma unroll
            for (int j = 0; j < 8; ++j) r[j] = o[j] * rs * hg[j] * siluf_(gt[j]);
            w.x = cvtpk_s(r[0], r[1]); w.y = cvtpk_s(r[2], r[3]); w.z = cvtpk_s(r[4], r[5]); w.w = cvtpk_s(r[6], r[7]);
            *(u32x4*)(mixed + (size_t)(t0 + t) * DM + CWID + 8 * lane) = w;
        }
    }
#undef P5_LOAD
}

DI void p6_rows(Frame& F) {
    KArgs* Ap = kargs_fresh(); KArgs& A = *Ap; const float* const mod = WSP(float, Ap, WS_MOD); unsigned char* const h20 = WSP(unsigned char, Ap, WS_H2); float* const probs = WSP(float, Ap, WS_PROBS); const bf16_t* const mix0 = WSP(bf16_t, Ap, WS_MIX);
    const int lane = F.lane, tid = F.tid;
    LAS float* rw = (LAS float*)F.lds;
    LAS float* ps = (LAS float*)(F.lds + 65536);
    for (int i = tid; i < DM * NE / 4; i += NTHR) { const int col = i >> 2, e4 = i & 3, l = (col & 255) >> 2, cc = col & 3, j = col >> 8;
        *(LAS f32x4*)(rw + ((((j * 4 + cc) * 4 + e4) * 64 + l) << 2)) = *(const f32x4*)(A.router + 4 * i); }
    __syncthreads();
    for (int tile = F.b0 * 16 + F.blk; tile < (F.b0 + F.nb) * 16; tile += F.nblk) {
        const int b = tile >> 4; const float* md = mod + (size_t)b * MODW;
        unsigned char* const h2 = h20 + fix_h2(tile >> 7); const bf16_t* const mix = mix0 + fix_mix(tile >> 7) / 2;
        f32x4 gg[4], sh[4];
#pragma unroll
        for (int j = 0; j < 4; ++j) { const int col = 4 * lane + 256 * j; gg[j] = *(const f32x4*)(A.norm2_g + col) * (*(const f32x4*)(md + 4 * DM + col) + 1.0f); sh[j] = *(const f32x4*)(md + 3 * DM + col); }
        u32x2 mr[2][4];
#define P6_LOAD(it_) do { const int tk_ = tile * 256 + (it_) * 16 + F.wave * 2; _Pragma("unroll") for (int t = 0; t < 2; ++t) _Pragma("unroll") for (int j = 0; j < 4; ++j) { \
            const size_t eo = (size_t)(tk_ + t) * DM + 4 * lane + 256 * j; mr[t][j] = *(const u32x2*)(mix + eo); } } while (0)
        P6_LOAD(0);
#pragma unroll 1
        for (int it = 0; it < 16; ++it) {
            const int tl = it * 16 + F.wave * 2, tok0 = tile * 256 + tl;
            f32x4 y[2][4]; float ss[2];
#pragma unroll
            for (int t = 0; t < 2; ++t) { ss[t] = 0.f;
#pragma unroll
                for (int j = 0; j < 4; ++j) { const f32x4 mv = {bflo(mr[t][j].x), bfhi(mr[t][j].x), bflo(mr[t][j].y), bfhi(mr[t][j].y)};
                    y[t][j] = mv; ss[t] += (y[t][j].x * y[t][j].x + y[t][j].y * y[t][j].y) + (y[t][j].z * y[t][j].z + y[t][j].w * y[t][j].w); } }
            if (it + 1 < 16) P6_LOAD(it + 1);
#pragma unroll
            for (int t = 0; t < 2; ++t) { const float rstd = rsqrtf(wave_sum(ss[t]) * (1.0f / DM) + EPS);
#pragma unroll
                for (int j = 0; j < 4; ++j) { y[t][j] = y[t][j] * rstd * gg[j] + sh[j];
                    *(unsigned*)(h2 + (size_t)(tok0 + t) * DM + 4 * lane + 256 * j) = pk4_fp8(y[t][j].x, y[t][j].y, y[t][j].z, y[t][j].w); } }
            float lg[32];
#pragma unroll
            for (int i = 0; i < 32; ++i) lg[i] = 0.f;
#pragma unroll
            for (int j = 0; j < 4; ++j)
#pragma unroll
                for (int cc = 0; cc < 4; ++cc) {
                    f32x4 r4[4];
#pragma unroll
                    for (int e4 = 0; e4 < 4; ++e4) r4[e4] = *(const LAS f32x4*)(rw + ((((j * 4 + cc) * 4 + e4) * 64 + lane) << 2));
#pragma unroll
                    for (int t = 0; t < 2; ++t)
#pragma unroll
                        for (int e4 = 0; e4 < 4; ++e4)
#pragma unroll
                            for (int q = 0; q < 4; ++q) lg[t * 16 + e4 * 4 + q] += y[t][j][cc] * r4[e4][q];
                }
#define P6_BFLY(off, lb) do { const bool up = (lane & (lb)) != 0; _Pragma("unroll") for (int i = 0; i < (off); ++i) { const float keep = up ? lg[i + (off)] : lg[i], send = up ? lg[i] : lg[i + (off)]; lg[i] = keep + __shfl_xor(send, (lb)); } } while (0)
            P6_BFLY(16, 32); P6_BFLY(8, 16); P6_BFLY(4, 8); P6_BFLY(2, 4); P6_BFLY(1, 2);
#undef P6_BFLY
            float v = lg[0] + __shfl_xor(lg[0], 1), mx = v;
#pragma unroll
            for (int o = 2; o < 32; o <<= 1) mx = fmaxf(mx, __shfl_xor(mx, o));
            const float ev = __expf(v - mx); float den = ev;
#pragma unroll
            for (int o = 2; o < 32; o <<= 1) den += __shfl_xor(den, o);
            if (!(lane & 1)) ps[((lane >> 1) & 15) * 256 + tl + (lane >> 5)] = ev * __builtin_amdgcn_rcpf(den);
        }
#undef P6_LOAD
        __syncthreads();
        { const int n0 = (tile & 15) * 256;
#pragma unroll
          for (int k = 0; k < 2; ++k) { const int i = tid + NTHR * k, e = i >> 6, c4 = (i & 63) * 4;
              *(f32x4*)(probs + ((size_t)(b * NE + e)) * SEQ + n0 + c4) = *(const LAS f32x4*)(ps + e * 256 + c4); } }
        __syncthreads();
    }
}

DI void topk_item(Frame& F, int g) {
    const int tid = F.tid, lane = F.lane, wave = F.wave;
    LAS int* hist = (LAS int*)F.lds; LAS int* scan = hist + 256; LAS int* misc = scan + 256;
    KArgs* Ap = kargs_fresh(); int* const idx = WSP(int, Ap, WS_IDX); float* const gate = WSP(float, Ap, WS_GATE); int* const sel = WSP(int, Ap, WS_SEL);
    const float* pr = WSP(float, Ap, WS_PROBS) + (size_t)g * SEQ + tid * 8;
    const u32x4 p0 = *(const u32x4*)pr, p1 = *(const u32x4*)(pr + 4);
    const unsigned u[8] = {p0.x, p0.y, p0.z, p0.w, p1.x, p1.y, p1.z, p1.w};
    unsigned prefix = 0; int need = CAP;
    for (int pass = 0; pass < 4; ++pass) {
        const int shift = 24 - 8 * pass;
        __syncthreads();
        if (tid < 256) hist[tid] = 0;
        __syncthreads();
#pragma unroll
        for (int j = 0; j < 8; ++j) { const bool match = (pass == 0) || ((u[j] >> (shift + 8)) == prefix);
            if (match) __hip_atomic_fetch_add(hist + ((u[j] >> shift) & 255u), 1, __ATOMIC_RELAXED, __HIP_MEMORY_SCOPE_WORKGROUP); }
        __syncthreads();
        if (wave == 0) {
            const int h0 = hist[4 * lane], h1 = hist[4 * lane + 1], h2 = hist[4 * lane + 2], h3 = hist[4 * lane + 3];
            const int s3 = h3, s2 = h2 + s3, s1 = h1 + s2, s0 = h0 + s1;
            int inc = s0;
#pragma unroll
            for (int o = 1; o < 64; o <<= 1) { const int t = __shfl_down(inc, o); if (lane + o < 64) inc += t; }
            const int above = inc - s0;
            scan[4 * lane] = s0 + above; scan[4 * lane + 1] = s1 + above; scan[4 * lane + 2] = s2 + above; scan[4 * lane + 3] = s3 + above;
        }
        __syncthreads();
        if (tid < 256) { const int incl = scan[tid], above = (tid < 255) ? scan[tid + 1] : 0; if (incl >= need && above < need) { misc[0] = tid; misc[1] = above; } }
        __syncthreads();
        prefix = (prefix << 8) | (unsigned)misc[0]; need -= misc[1];
    }
    const unsigned T = prefix;
    int cg = 0, ce = 0;
#pragma unroll
    for (int j = 0; j < 8; ++j) { cg += (u[j] > T); ce += (u[j] == T); }
    int pk = cg | (ce << 16), inc = pk;
#pragma unroll
    for (int o = 1; o < 64; o <<= 1) { const int t = __shfl_up(inc, o); if (lane >= o) inc += t; }
    __syncthreads();
    if (lane == 63) misc[8 + wave] = inc;
    __syncthreads();
    int base = 0;
#pragma unroll
    for (int w = 0; w < NWAVES; ++w) if (w < wave) base += misc[8 + w];
    const int excl = base + inc - pk; int rg = excl & 0xffff, re = excl >> 16;
    const int cgt = CAP - need;
    const int b = g >> 4, e = g & 15;
#pragma unroll
    for (int j = 0; j < 8; ++j) { const int n = tid * 8 + j; int slot = -1;
        if (u[j] > T) { slot = rg; ++rg; } else if (u[j] == T) { if (re < need) slot = cgt + re; ++re; }
        if (slot >= 0) { idx[g * CAP + slot] = n; gate[g * CAP + slot] = __uint_as_float(u[j]); }
        sel[((size_t)(b * SEQ + n)) * NE + e] = slot; }
}

DI void p10_final(Frame& F) {
    KArgs* Ap = kargs_fresh(); KArgs& A = *Ap; const float* const mod = WSP(float, Ap, WS_MOD); const int* const sel = WSP(int, Ap, WS_SEL); const bf16_t* const mout0 = WSP(bf16_t, Ap, WS_MOUT); const bf16_t* const mix0 = WSP(bf16_t, Ap, WS_MIX); const float* const gate = WSP(float, Ap, WS_GATE);
    const int gw = F.blk * NWAVES + F.wave, ngw = F.nblk * NWAVES, lane = F.lane;
    const int tbeg = F.b0 * SEQ, tend = (F.b0 + F.nb) * SEQ;
    int svn = (tbeg + gw < tend && lane < NE) ? sel[(size_t)(tbeg + gw) * NE + lane] : -1;
    for (int tok = tbeg + gw; tok < tend; tok += ngw) {
        const int b = tok >> 12; const float* md = mod + (size_t)b * MODW + 5 * DM;
        const bf16_t* const mout = mout0 + fix_mout(b >> 3) / 2; const bf16_t* const mix = mix0 + fix_mix(b >> 3) / 2;
        const int sv = svn;
        if (tok + ngw < tend) svn = (lane < NE) ? sel[(size_t)(tok + ngw) * NE + lane] : -1;
        float* xr = A.out + (size_t)tok * DM;
        u32x4 mw2[2];
#pragma unroll
        for (int hlf = 0; hlf < 2; ++hlf) mw2[hlf] = *(const u32x4*)(mix + (size_t)tok * DM + hlf * 512 + 8 * lane);
        float y[16];
#pragma unroll
        for (int j = 0; j < 16; ++j) y[j] = 0.f;
#pragma unroll
        for (int e = 0; e < NE; ++e) { const int s = __builtin_amdgcn_readlane(sv, e);
            if (s >= 0) { const size_t ri = (size_t)(b * NE + e) * CAP + s; const bf16_t* row = mout + ri * DM;
                const float gt = __hip_atomic_load(gate + ri, __ATOMIC_RELAXED, __HIP_MEMORY_SCOPE_AGENT);
                const u32x4 w0 = *(const u32x4*)(row + 8 * lane), w1 = *(const u32x4*)(row + 512 + 8 * lane);
                y[0] += gt * bflo(w0.x); y[1] += gt * bfhi(w0.x); y[2] += gt * bflo(w0.y); y[3] += gt * bfhi(w0.y); y[4] += gt * bflo(w0.z); y[5] += gt * bfhi(w0.z); y[6] += gt * bflo(w0.w); y[7] += gt * bfhi(w0.w);
                y[8] += gt * bflo(w1.x); y[9] += gt * bfhi(w1.x); y[10] += gt * bflo(w1.y); y[11] += gt * bfhi(w1.y); y[12] += gt * bflo(w1.z); y[13] += gt * bfhi(w1.z); y[14] += gt * bflo(w1.w); y[15] += gt * bfhi(w1.w); } }
        float xf[16]; float ss = 0.f;
#pragma unroll
        for (int hlf = 0; hlf < 2; ++hlf) { const u32x4 mw = mw2[hlf];
            const float mv[8] = {bflo(mw.x), bfhi(mw.x), bflo(mw.y), bfhi(mw.y), bflo(mw.z), bfhi(mw.z), bflo(mw.w), bfhi(mw.w)};
#pragma unroll
            for (int q = 0; q < 2; ++q) { const int col = hlf * 512 + 8 * lane + 4 * q; const f32x4 g2 = *(const f32x4*)(md + col);
#pragma unroll
                for (int j = 0; j < 4; ++j) { const float t = mv[q * 4 + j] + g2[j] * y[hlf * 8 + q * 4 + j]; xf[hlf * 8 + q * 4 + j] = t; ss += t * t; } } }
        const float rstd = rsqrtf(wave_sum(ss) * (1.0f / DM) + EPS);
#pragma unroll
        for (int hlf = 0; hlf < 2; ++hlf)
#pragma unroll
            for (int q = 0; q < 2; ++q) { const int col = hlf * 512 + 8 * lane + 4 * q; const f32x4 fg = *(const f32x4*)(A.final_g + col); f32x4 o;
#pragma unroll
                for (int j = 0; j < 4; ++j) o[j] = xf[hlf * 8 + q * 4 + j] * rstd * fg[j];
                *(f32x4*)(xr + col) = o; }
    }
}

constexpr int CW_CTX = 96;
DI void block_handoff(Frame& F) { asm volatile("s_waitcnt vmcnt(0)" ::: "memory"); __syncthreads(); if (F.tid == 0) { __builtin_amdgcn_fence(__ATOMIC_ACQUIRE, "agent"); asm volatile("s_waitcnt vmcnt(0)" ::: "memory"); } __syncthreads(); frame_refresh(F); }
constexpr int CW_WFLAG = 64;
__global__ void __launch_bounds__(NTHR, 2) hymba_fwd(Args args) {
    extern __shared__ __attribute__((aligned(16))) unsigned char lds_raw[];
    Frame F;
    F.lds = (LAS unsigned char*)lds_raw; F.wave = __builtin_amdgcn_readfirstlane((int)threadIdx.x >> 6); frame_refresh(F);
    const int gblk = blockIdx.x, gn = gridDim.x;
    const int nl = (gn % 16 == 0) ? N_LANES : 1;
    const int lid = nl == 2 ? ((gblk >> 3) & 1) : 0, lblk = nl == 2 ? ((gblk & 7) | ((gblk >> 4) << 3)) : gblk, lnblk = gn / nl;
    volatile LAS unsigned* MISC = (volatile LAS unsigned*)(F.lds + MISC_OFF);
    if (F.tid < 32) MISC[F.tid] = 0u;
    __syncthreads();
    unsigned* const ctl = (unsigned*)(args.ws + WS_CTL);
    XcdBarrier gbar = xcd_barrier_post(ctl + 4096, MISC + 8, F.tid == 0, (unsigned)gn);
    XcdBarrier lbar = xcd_barrier_post(ctl + 4096 + (1 + lid) * XCD_BAR_WORDS, MISC + 10, F.tid == 0, (unsigned)lnblk);
#define LBAR() do { frame_refresh(F); xcd_barrier(lbar, F.tid == 0); frame_refresh(F); } while (0)

    F.blk = gblk; F.nblk = gn; F.b0 = 0; F.nb = NB;
    p0_prologue(F); __syncthreads(); p0_transposes<0>(F);
    frame_refresh(F); xcd_barrier(gbar, F.tid == 0); frame_refresh(F);

    F.blk = lblk; F.nblk = lnblk; F.nb = NB / nl; F.b0 = lid * F.nb;
    if (lid == nl - 1) {
        p0_transposes<1>(F);
        LBAR();
        if (lblk == 0 && F.tid == 0) __hip_atomic_store(ctl + CW_WFLAG, 1u, __ATOMIC_RELAXED, __HIP_MEMORY_SCOPE_AGENT);
    }
    p1_rows(F, MTOK + F.b0 * CTXL, F.nb * CTXL, F.blk * NWAVES + F.wave, F.nblk * NWAVES);
    block_handoff(F);
    if (F.tid == 0) { __builtin_amdgcn_fence(__ATOMIC_RELEASE, "agent"); asm volatile("s_waitcnt vmcnt(0)" ::: "memory"); (void)xb_add(ctl + CW_CTX + lid, 1u); }
    for (int tile = F.b0 * 16 + F.blk; tile < (F.b0 + F.nb) * 16; tile += F.nblk) p1_rows(F, tile * 256, 256, F.wave, NWAVES);
    block_handoff(F);
    { KArgs* Ap = kargs_fresh(); ProbDense P; P.A = WSP(bf16_t, Ap, WS_H); P.Bt = WSP(bf16_t, Ap, WS_WIN); P.K = DM; P.ord.init_own(F.nb * 16, INC / 256, F.nblk, F.blk, F.b0 * 16);
      EpiPlanes E{WSP(bf16_t, Ap, WS_PL)}; pg8::gemm_phase<ProbDense, EpiPlanes, true>(F.lds, F.tid, P, E); }
    frame_refresh(F);
    {
        if (F.tid == 0) { unsigned sp = 0; while (xb_ld(ctl + CW_CTX + lid) < (unsigned)F.nblk) { __builtin_amdgcn_s_sleep(8); if (++sp > (1u << 22)) break; }
            __builtin_amdgcn_fence(__ATOMIC_ACQUIRE, "agent"); asm volatile("s_waitcnt vmcnt(0)" ::: "memory"); }
        __syncthreads();
        KArgs* Ap = kargs_fresh(); ProbDense P; P.A = WSP(bf16_t, Ap, WS_H) + (size_t)MTOK * DM; P.Bt = WSP(bf16_t, Ap, WS_WIN) + (size_t)OFF_I * DM; P.K = DM; P.ord.init(F.nb, PCW / 256, F.nblk, F.blk, F.b0);
        EpiCtxPlanes E{WSP(bf16_t, Ap, WS_PCTX)}; pg8::gemm_phase<ProbDense, EpiCtxPlanes, true>(F.lds, F.tid, P, E);
    }
    LBAR();
    {
        const int gwv = F.blk * NWAVES + F.wave, ngw = F.nblk * NWAVES, nconv = F.nb * 64 * 2 * 2, nprep = F.nb * 64 * NH + F.nb * 4 * NH;
        const bool prep_first = F.wave >= 4;
        if (prep_first) for (int it = gwv; it < nprep; it += ngw) prep_item(F, it);
        for (int it = gwv; it < nconv; it += ngw) conv_item(F, it);
        if (!prep_first) for (int it = gwv; it < nprep; it += ngw) prep_item(F, it);
    }
    LBAR();
    {
        const int nscan = F.nb * NH * 2 * 2;
        for (int it = F.blk; it < nscan; it += F.nblk) { const int x = it & 7, y = it >> 3; scan_item(F, ((x + 8 * (y >> 1)) << 1) | (y & 1)); }
    }
    LBAR();
    for (int tile = F.b0 * 16 + F.blk; tile < (F.b0 + F.nb) * 16; tile += F.nblk) p4_mixed(F, tile * 256, tile * 256 + 256, F.wave, NWAVES);
    block_handoff(F);
    { KArgs* Ap = kargs_fresh(); ProbDense P; P.A = WSP(bf16_t, Ap, WS_H); P.Bt = WSP(bf16_t, Ap, WS_WOUT); P.K = DM; P.ord.init_own(F.nb * 16, DM / 256, F.nblk, F.blk, F.b0 * 16);
      EpiX1 E{WSP(bf16_t, Ap, WS_MIX), Ap->x, WSP(float, Ap, WS_MOD)}; pg8::gemm_phase<ProbDense, EpiX1, true>(F.lds, F.tid, P, E); }
    block_handoff(F);
    p6_rows(F);
    LBAR();
    {
        if (F.tid == 0) { unsigned sp = 0; while (__hip_atomic_load(ctl + CW_WFLAG, __ATOMIC_RELAXED, __HIP_MEMORY_SCOPE_AGENT) == 0u) { __builtin_amdgcn_s_sleep(8); if (++sp > (1u << 22)) break; }
            __builtin_amdgcn_fence(__ATOMIC_ACQUIRE, "agent"); asm volatile("s_waitcnt vmcnt(0)" ::: "memory"); }
        __syncthreads();
    }
    for (int gl = F.blk; gl < F.nb * NE; gl += F.nblk) {
        const int e = 2 * (gl & 7) + ((gl >> 3) & 1), b = F.b0 + (gl >> 4), g = b * NE + e, gm = e * 32 + b * 2;
        topk_item(F, g);
        block_handoff(F);
        { KArgs* Ap = kargs_fresh(); ProbMoeUp P; P.A = WSP(unsigned char, Ap, WS_H2); P.Bt = WSP(unsigned char, Ap, WS_WGU); P.idx = WSP(int, Ap, WS_IDX); P.K = DM; P.ord.init_group(2 * FF / 256, gm);
          EpiSwiglu E{WSP(unsigned char, Ap, WS_HID)}; pg8::gemm_phase<ProbMoeUp, EpiSwiglu, true>(F.lds, F.tid, P, E); }
        block_handoff(F);
        { KArgs* Ap = kargs_fresh(); ProbMoeDown P; P.A = WSP(unsigned char, Ap, WS_HID); P.Bt = WSP(unsigned char, Ap, WS_WDN); P.K = FF; P.ord.init_group(DM / 256, gm);
          EpiDown E{WSP(bf16_t, Ap, WS_MOUT)}; pg8::gemm_phase<ProbMoeDown, EpiDown, true>(F.lds, F.tid, P, E); }
        frame_refresh(F);
    }
    LBAR();
    p10_final(F);
#undef LBAR
}

extern "C" void kernel_launch(void* const* d_in, const int* in_sizes, int n_in, void* d_out, int out_size, void* d_ws, size_t ws_size, hipStream_t stream) {
    static int grid = 0;
    if (grid == 0) {
        if (n_in != 21 || in_sizes[0] != MTOK * DM || out_size != MTOK * DM || ws_size < WS_END) { fprintf(stderr, "kernel_launch: unexpected shapes (n_in %d, in0 %d, out %d, ws %zu)\n", n_in, n_in > 0 ? in_sizes[0] : -1, out_size, ws_size); grid = -1; return; }
        int dev = 0, cus = 0, per_cu = 0;
        if (hipGetDevice(&dev) != hipSuccess || hipDeviceGetAttribute(&cus, hipDeviceAttributeMultiprocessorCount, dev) != hipSuccess) { grid = -1; return; }
        if (hipFuncSetAttribute((const void*)hymba_fwd, hipFuncAttributeMaxDynamicSharedMemorySize, LDS_BYTES) != hipSuccess) { fprintf(stderr, "kernel_launch: hipFuncSetAttribute failed\n"); grid = -1; return; }
        if (hipOccupancyMaxActiveBlocksPerMultiprocessor(&per_cu, (const void*)hymba_fwd, NTHR, LDS_BYTES) != hipSuccess || per_cu < 1) { fprintf(stderr, "kernel_launch: occupancy query says %d\n", per_cu); per_cu = 1; }
        (void)hipGetLastError();
        grid = cus * (per_cu < 1 ? 1 : 1);
    }
    if (grid < 0) return;
    Args a{};
    const float** ap = (const float**)&a;
    for (int i = 0; i < 21; ++i) ap[i] = (const float*)d_in[i];
    a.out = (float*)d_out; a.ws = (unsigned char*)d_ws;
#if BARRIER_KIND == 1
    if (hipMemsetAsync((char*)d_ws + WS_CTL, 0, 65536, stream) != hipSuccess) { fprintf(stderr, "kernel_launch: memset failed\n"); return; }
#endif
    void* kargs[] = {&a};
    const hipError_t le = hipLaunchCooperativeKernel((const void*)hymba_fwd, dim3(grid), dim3(NTHR), kargs, LDS_BYTES, stream);
    if (le != hipSuccess) fprintf(stderr, "kernel_launch: cooperative launch failed: %s (grid %d)\n", hipGetErrorString(le), grid);
}
```

```cpp
#include <hip/hip_runtime.h>
#include <hip/hip_cooperative_groups.h>
#include <cstdio>
namespace cg = cooperative_groups;

#ifndef BARRIER_KIND
#define BARRIER_KIND 1
#endif
#ifndef N_LANES
#define N_LANES 2
#endif

#define LAS __attribute__((address_space(3)))
#define DI __device__ __forceinline__
typedef unsigned short bf16_t;
typedef short bf16x8 __attribute__((ext_vector_type(8)));
typedef float f32x4 __attribute__((ext_vector_type(4)));
typedef float f32x2 __attribute__((ext_vector_type(2)));
typedef unsigned u32x4 __attribute__((ext_vector_type(4)));
typedef unsigned u32x2 __attribute__((ext_vector_type(2)));

constexpr int NB = 16, SEQ = 4096, DM = 1024, MTOK = NB * SEQ, CTXL = 256, MCTX = NB * CTXL;
constexpr int GW = 64;
constexpr int CWID = 512, HWID = 512, HD = 128, NH = 4, CK = 31, CPAD = 15;
constexpr int NE = 16, FF = 1024, CAP = 512, NGRP = NB * NE, MROWS = NGRP * CAP;
constexpr int OFF_A = 0, OFF_B = 512, OFF_Q = 1024, OFF_I = 1536, OFF_FF = 2048, OFF_FB = 2560, OFF_G = 3072, INC = 3584;
constexpr int PCW = 1536;
constexpr int MODW = 6 * DM;
constexpr float EPS = 1e-6f;

constexpr size_t MiB = 1u << 20;
constexpr size_t WS_CTL = 0;
constexpr size_t WS_MOD = 1 * MiB;
constexpr size_t WS_LB = WS_MOD + 512 * 1024;
constexpr size_t WS_PROBS = 2 * MiB;
constexpr size_t WS_IDX = 6 * MiB;
constexpr size_t WS_GATE = 6 * MiB + 512 * 1024;
constexpr size_t WS_SEL = 7 * MiB;
constexpr size_t WS_WIN = 16 * MiB;
constexpr size_t WS_WOUT = 23 * MiB;
constexpr size_t WS_WGU = 25 * MiB;
constexpr size_t WS_WDN = 89 * MiB;
constexpr size_t WS_H = 128 * MiB;
constexpr size_t WS_PL = 264 * MiB;
constexpr size_t PLANE = 8 * MiB;
constexpr size_t HREG = 40 * PLANE;
DI size_t fix_pl(int h) { return (size_t)h * (HREG - PLANE); }
DI size_t fix_h2(int h) { return (size_t)h * (HREG - 32 * MiB); }
DI size_t fix_mix(int h) { return (size_t)h * (HREG - 64 * MiB); }
DI size_t fix_hid(int h) { return (size_t)h * (HREG - 64 * MiB); }
DI size_t fix_mout(int h) { return (size_t)h * (HREG - 128 * MiB); }
constexpr int PL_U = 0, PL_Q = 4, PL_I = 8, PL_FF = 12, PL_FB = 16, PL_G = 20, PL_QB = 24, PL_OF = 28, PL_OB = 32, PL_CPRE = 36, NPLANES = 40;
constexpr size_t WS_PCTX = 904 * MiB;
constexpr size_t CPLANE = 1 * MiB;
constexpr size_t WS_EARR = 916 * MiB;
constexpr size_t WS_H2 = WS_PL;
constexpr size_t WS_HID = WS_PL + 12 * PLANE;
constexpr size_t WS_MOUT = WS_PL + 20 * PLANE;
constexpr size_t WS_MIX = WS_PL + 4 * PLANE;
constexpr size_t WS_END = 922 * MiB;
static_assert(WS_PL + 2 * HREG <= WS_PCTX, "plane regions");
constexpr int NCHK = 4 + 64;

constexpr int LDS_BYTES = 147456, MISC_OFF = 147456 - 128;
constexpr int NTHR = 512, NWAVES = 8;

struct Args {
    const float *x, *c, *ctx, *c_ctx, *ada_w, *ada_b, *norm1_g, *w_in, *taps, *conv_bias, *ln_g, *ln_b, *lb_logits, *hgrn_g, *w_out, *norm2_g, *router, *w_gate, *w_up, *w_down, *final_g;
    float* out; unsigned char* ws; int ph_lo, ph_hi;
};

DI float bf2f(bf16_t b) { return __uint_as_float(((unsigned)b) << 16); }
DI unsigned f2bf(float f) { unsigned u = __float_as_uint(f); return (u + 0x7fffu + ((u >> 16) & 1u)) >> 16; }
DI unsigned pk2(float lo, float hi) { return f2bf(lo) | (f2bf(hi) << 16); }
DI float bflo(unsigned w) { return __uint_as_float(w << 16); }
DI float bfhi(unsigned w) { return __uint_as_float(w & 0xffff0000u); }
DI float sigmoidf_(float x) { return __builtin_amdgcn_rcpf(1.0f + __expf(-x)); }
DI float siluf_(float x) { return x * __builtin_amdgcn_rcpf(1.0f + __expf(-x)); }
DI float wave_sum(float v) {
#pragma unroll
    for (int o = 1; o < 64; o <<= 1) v += __shfl_xor(v, o);
    return v;
}
typedef float f32x2_t __attribute__((ext_vector_type(2))); typedef __bf16 bf16x2_t __attribute__((ext_vector_type(2)));
DI unsigned cvtpk_s(float lo, float hi) { f32x2_t v = {lo, hi}; bf16x2_t b = __builtin_convertvector(v, bf16x2_t); return __builtin_bit_cast(unsigned, b); }

namespace pg8 {
constexpr int BM = 256, BK = 64, HALF = 128, HTB = HALF * BK * 2, STAGE_BYTES = 8 * HTB, NXCD = 8, WGM = 8;
DI int lds_byte(int r, int c) { const int st = (r >> 4) * 2 + (c >> 5), rr = r & 15, cc = c & 31, ob = rr * 64 + cc * 2; return st * 1024 + (ob ^ (((ob >> 9) & 1) << 5)); }
DI void stage_rc(int b, int& R, int& C) { const int st = b / 1024, sb = b % 1024, swz = sb ^ (((sb >> 9) & 1) << 5); R = (st >> 1) * 16 + swz / 64; C = (st & 1) * 32 + (swz % 64) / 2; }
DI int perm32(int rho) { const int n = rho >> 4, i = rho & 15; return 8 * (i >> 2) + 4 * n + (i & 3); }
struct Unit { int pm, pn; };
typedef int v8i __attribute__((ext_vector_type(8))); typedef int v4i __attribute__((ext_vector_type(4)));
DI void mfma_fp8(f32x4& acc, const v8i& a, const v8i& b, int sc) { asm volatile("v_mfma_scale_f32_16x16x128_f8f6f4 %0, %1, %2, %0, %3, %3 op_sel_hi:[0,0,0]" : "+v"(acc) : "v"(a), "v"(b), "v"(sc)); }
DI v8i cat8(bf16x8 a, bf16x8 b) { return __builtin_shufflevector(__builtin_bit_cast(v4i, a), __builtin_bit_cast(v4i, b), 0, 1, 2, 3, 4, 5, 6, 7); }

struct TileOrder {
    int nM, nN, nwg, G, c, pm0, moe_b0, gm; bool own;
    DI void init(int nM_, int nN_, int G_, int c_, int pm0_ = 0, int moe_b0_ = -1) { nM = nM_; nN = nN_; nwg = nM * nN; G = G_; c = c_; pm0 = pm0_; moe_b0 = moe_b0_; own = false; gm = -1; }
    DI void init_own(int nM_, int nN_, int G_, int c_, int pm0_) { init(nM_, nN_, G_, c_, pm0_); own = true; }
    DI void init_group(int nN_, int gm_) { init(2, nN_, 1, 0); gm = gm_; }
    DI bool next(int i, Unit& u) const {
        if (gm >= 0) { if (i >= 2 * nN) return false; const int r = i >= nN ? 1 : 0; u.pn = i - r * nN; u.pm = gm + r; return true; }
        if (own) { const int r = i / nN, pml = c + r * G; if (pml >= nM) return false; u.pn = i - r * nN; u.pm = pml + pm0; return true; }
        const long L = (long)i * G + c; if (L >= nwg) return false;
        int wgid = (int)L; { const int q = nwg / NXCD, r = nwg % NXCD, xcd = wgid % NXCD, off = wgid / NXCD; wgid = (xcd < r ? xcd * (q + 1) : r * (q + 1) + (xcd - r) * q) + off; }
        const int nig = WGM * nN, gid = wgid / nig, fm = gid * WGM, gsz = (nM - fm) < WGM ? (nM - fm) : WGM;
        const int pml = fm + ((wgid % nig) % gsz); u.pn = (wgid % nig) / gsz;
        u.pm = moe_b0 >= 0 ? ((pml >> 4) * 32 + (moe_b0 + ((pml >> 1) & 7)) * 2 + (pml & 1)) : pml + pm0; return true;
    }
};

template <class Prob, class Epi, bool ALIGN_EPI>
DI void gemm_phase(LAS unsigned char* lds, const int tid, const Prob& P, const Epi& E) {
    constexpr bool GATHER = Prob::GATHER, FP8 = Prob::FP8;
    const int wid = __builtin_amdgcn_readfirstlane(tid >> 6), lane = tid & 63, wr = wid >> 2, wc = wid & 3, fr = lane & 15, fq = lane >> 4;
    const int KB = P.K * (FP8 ? 1 : 2), nt = KB / 128;
    unsigned voffA[2], voffB[2];
#pragma unroll
    for (int i = 0; i < 2; ++i) { int R, C; stage_rc(tid * 16 + i * 8192, R, C); const int Rb = Epi::PERM ? ((R & ~31) + perm32(R & 31)) : R; voffA[i] = (unsigned)(R * KB + C * 2); voffB[i] = (unsigned)(Rb * KB + C * 2); }
    const unsigned kstep = 128u;
    const size_t hstep = (size_t)HALF * KB;
    const unsigned ldsw = (unsigned)wid * 1024u;
    const int aoff = lds_byte(wr * 64 + fr, fq * 8), boff = lds_byte(wc * 32 + fr, fq * 8);
#define PG8_SA(b, h) (((b) * 2 + (h)) * HTB)
#define PG8_SB(b, h) ((4 + (b) * 2 + (h)) * HTB)
#define PG8_STAGE(bufoff, gbase, voff) do { _Pragma("unroll") for (int _i = 0; _i < 2; ++_i) \
        __builtin_amdgcn_global_load_lds((const unsigned*)((const char*)(gbase) + (voff)[_i]), (LAS unsigned*)(lds + (bufoff) + ldsw + _i * 8192), 16, 0, 0); } while (0)
#define PG8_LDA(dst, b, h) do { _Pragma("unroll") for (int m = 0; m < 4; ++m) { if constexpr (FP8) { dst##8[m] = cat8(*(const LAS bf16x8*)(lds + PG8_SA(b, h) + aoff + m * 2048), *(const LAS bf16x8*)(lds + PG8_SA(b, h) + aoff + m * 2048 + 1024)); } \
        else { _Pragma("unroll") for (int k = 0; k < 2; ++k) dst[m][k] = *(const LAS bf16x8*)(lds + PG8_SA(b, h) + aoff + m * 2048 + k * 1024); } } } while (0)
#define PG8_LDB(dst, b, h) do { _Pragma("unroll") for (int n = 0; n < 2; ++n) { if constexpr (FP8) { dst##8[n] = cat8(*(const LAS bf16x8*)(lds + PG8_SB(b, h) + boff + n * 2048), *(const LAS bf16x8*)(lds + PG8_SB(b, h) + boff + n * 2048 + 1024)); } \
        else { _Pragma("unroll") for (int k = 0; k < 2; ++k) dst[n][k] = *(const LAS bf16x8*)(lds + PG8_SB(b, h) + boff + n * 2048 + k * 1024); } } } while (0)
#define PG8_MMA(ai, bj, At, Bt) do { if constexpr (!FP8) __builtin_amdgcn_s_setprio(1); else asm volatile("s_setprio 1"); _Pragma("unroll") for (int m = 0; m < 4; ++m) _Pragma("unroll") for (int n = 0; n < 2; ++n) { \
        if constexpr (FP8) { mfma_fp8(acc[ai][bj][m][n], Bt##8[n], At##8[m], sc1); } \
        else { _Pragma("unroll") for (int k = 0; k < 2; ++k) acc[ai][bj][m][n] = __builtin_amdgcn_mfma_f32_16x16x32_bf16(Bt[n][k], At[m][k], acc[ai][bj][m][n], 0, 0, 0); } } \
        if constexpr (!FP8) __builtin_amdgcn_s_setprio(0); else asm volatile("s_setprio 0"); } while (0)
#define PG8_WAIT_V(n) asm volatile("s_waitcnt vmcnt(" #n ")" ::: "memory")
#define PG8_WAIT_L(n) asm volatile("s_waitcnt lgkmcnt(" #n ")" ::: "memory")
#define PG8_BAR __builtin_amdgcn_s_barrier()
#define PG8_SCHED __builtin_amdgcn_sched_barrier(0)
#define PG8_STA(buf, base, V, h) do { if constexpr (GATHER) { PG8_STAGE_G(buf, base, V, h); } else { PG8_STAGE(buf, base, V); } } while (0)
#define PG8_KBODY(A1, VA1, A2H0, V2, A2H1, A3H0, B2, B3) do { \
            PG8_LDB(B0, 0, 0); PG8_LDB(B1, 0, 1); PG8_SCHED; PG8_LDA(At, 0, 0); PG8_STA(PG8_SA(1, 1), A1, VA1, 1); \
            PG8_WAIT_V(8); PG8_WAIT_L(0); PG8_BAR; PG8_MMA(0, 0, At, B0); PG8_MMA(0, 1, At, B1); PG8_BAR; PG8_SCHED; \
            PG8_LDA(At, 0, 1); PG8_STAGE(PG8_SB(0, 0), B2, voffB); PG8_STAGE(PG8_SB(0, 1), (B2) + hstep, voffB); PG8_STA(PG8_SA(0, 0), A2H0, V2, 0); \
            PG8_WAIT_V(8); PG8_WAIT_L(0); PG8_BAR; PG8_MMA(1, 0, At, B0); PG8_MMA(1, 1, At, B1); PG8_BAR; PG8_SCHED; \
            PG8_LDB(B0, 1, 0); PG8_LDB(B1, 1, 1); PG8_SCHED; PG8_LDA(At, 1, 0); PG8_STA(PG8_SA(0, 1), A2H1, V2, 1); \
            PG8_WAIT_V(8); PG8_WAIT_L(0); PG8_BAR; PG8_MMA(0, 0, At, B0); PG8_MMA(0, 1, At, B1); PG8_BAR; PG8_SCHED; \
            PG8_LDA(At, 1, 1); PG8_STAGE(PG8_SB(1, 0), B3, voffB); PG8_STAGE(PG8_SB(1, 1), (B3) + hstep, voffB); PG8_STA(PG8_SA(1, 0), A3H0, V2, 0); \
            PG8_WAIT_V(8); PG8_WAIT_L(0); PG8_BAR; PG8_MMA(1, 0, At, B0); PG8_MMA(1, 1, At, B1); PG8_BAR; PG8_SCHED; } while (0)
    Unit cur, nxt; int ui = 0;
    if (!P.next(0, cur)) return;
    f32x4 acc[2][2][4][2];
#pragma unroll
    for (int a = 0; a < 2; ++a)
#pragma unroll
        for (int b = 0; b < 2; ++b)
#pragma unroll
            for (int m = 0; m < 4; ++m)
#pragma unroll
                for (int n = 0; n < 2; ++n) acc[a][b][m][n] = (f32x4){0.f, 0.f, 0.f, 0.f};
    int sc1 = 0x7f7f7f7f; asm volatile("" : "+v"(sc1));
    bf16x8 At[4][2], B0[2][2], B1[2][2]; v8i At8[4], B08[2], B18[2];
    unsigned pa[2], c2[2];
    const char* cA;
    if constexpr (GATHER) { P.a_rows(cur, tid, pa); cA = (const char*)P.a_base(cur);
#pragma unroll
        for (int i = 0; i < 2; ++i) { int R, C; stage_rc(tid * 16 + i * 8192, R, C); c2[i] = (unsigned)(C * 2); } }
    else { cA = (const char*)P.a_tile(cur); }
#define PG8_STAGE_G(bufoff, gbase, pk, h) do { _Pragma("unroll") for (int _i = 0; _i < 2; ++_i) { const unsigned _off = (((pk)[_i] >> (16 * (h))) & 0xffffu) * (unsigned)KB + c2[_i]; \
        __builtin_amdgcn_global_load_lds((const unsigned*)((const char*)(gbase) + _off), (LAS unsigned*)(lds + (bufoff) + ldsw + _i * 8192), 16, 0, 0); } } while (0)
    const char* cB = (const char*)P.b_base(cur);
    PG8_STAGE(PG8_SB(0, 0), cB, voffB); PG8_STAGE(PG8_SB(0, 1), cB + hstep, voffB);
    if constexpr (GATHER) { PG8_STAGE_G(PG8_SA(0, 0), cA, pa, 0); PG8_STAGE_G(PG8_SA(0, 1), cA, pa, 1); } else { PG8_STAGE(PG8_SA(0, 0), cA, voffA); PG8_STAGE(PG8_SA(0, 1), cA + hstep, voffA); }
    if (wr == 1) PG8_BAR;
    PG8_WAIT_V(2); PG8_BAR;
    PG8_STAGE(PG8_SB(1, 0), cB + kstep, voffB);
    if constexpr (GATHER) { PG8_STAGE_G(PG8_SA(1, 0), cA + kstep, pa, 0); } else { PG8_STAGE(PG8_SA(1, 0), cA + kstep, voffA); }
    PG8_STAGE(PG8_SB(1, 1), cB + hstep + kstep, voffB);
    PG8_WAIT_V(6); PG8_BAR;
    for (;;) {
        const bool has_next = P.next(ui + 1, nxt);
        const char* nB = has_next ? (const char*)P.b_base(nxt) : cB;
        if constexpr (GATHER) {
            unsigned pn[2]; const char* nA = has_next ? (const char*)P.a_base(nxt) : cA;
            if (has_next) P.a_rows(nxt, tid, pn); else { pn[0] = pa[0]; pn[1] = pa[1]; }
            for (int t = 0; t < nt; t += 2) {
                const bool last = (t == nt - 2);
                const char* a1 = cA + (size_t)(t + 1) * kstep;
                const char* a2 = last ? nA : cA + (size_t)(t + 2) * kstep; const char* b2 = last ? nB : cB + (size_t)(t + 2) * kstep;
                unsigned p2[2]; p2[0] = last ? pn[0] : pa[0]; p2[1] = last ? pn[1] : pa[1];
                PG8_KBODY(a1, pa, a2, p2, a2, a2 + kstep, b2, b2 + kstep); }
            pa[0] = pn[0]; pa[1] = pn[1]; cA = nA;
        } else {
            const char* nA = has_next ? (const char*)P.a_tile(nxt) : cA;
            for (int t = 0; t < nt; t += 2) {
                const bool last = (t == nt - 2);
                const char* a1 = cA + hstep + (size_t)(t + 1) * kstep;
                const char* a2 = last ? nA : cA + (size_t)(t + 2) * kstep; const char* b2 = last ? nB : cB + (size_t)(t + 2) * kstep;
                PG8_KBODY(a1, voffA, a2, voffA, a2 + hstep, a2 + kstep, b2, b2 + kstep); }
            cA = nA;
        }
        if constexpr (ALIGN_EPI) { if (wr == 0) PG8_BAR; }
        if constexpr (FP8) asm volatile("s_nop 15\n\ts_nop 15" ::: "memory");
        E(acc, cur, wr, wc, fr, fq);
        if (!has_next) break;
#pragma unroll
        for (int a = 0; a < 2; ++a)
#pragma unroll
            for (int b = 0; b < 2; ++b)
#pragma unroll
                for (int m = 0; m < 4; ++m)
#pragma unroll
                    for (int n = 0; n < 2; ++n) acc[a][b][m][n] = (f32x4){0.f, 0.f, 0.f, 0.f};
        cur = nxt; cB = nB; ++ui;
        if constexpr (ALIGN_EPI) { if (wr == 1) PG8_BAR; }
    }
    PG8_WAIT_V(0);
    if constexpr (!ALIGN_EPI) { if (wr == 0) PG8_BAR; }
    PG8_BAR;
#undef PG8_KBODY
#undef PG8_STA
#undef PG8_STAGE_G
#undef PG8_SA
#undef PG8_SB
#undef PG8_STAGE
#undef PG8_LDA
#undef PG8_LDB
#undef PG8_MMA
#undef PG8_WAIT_V
#undef PG8_WAIT_L
#undef PG8_BAR
#undef PG8_SCHED
}
}
using pg8::Unit;

struct ProbDense {
    static constexpr bool GATHER = false, FP8 = false;
    const bf16_t* A; const bf16_t* Bt; int K; pg8::TileOrder ord;
    DI bool next(int i, Unit& u) const { return ord.next(i, u); }
    DI const void* a_tile(const Unit& u) const { return A + (size_t)u.pm * 256 * K; }
    DI const void* b_base(const Unit& u) const { return Bt + (size_t)u.pn * 256 * K; }
};
DI void moe_unit(int pmv, int& g, int& half, int& e) { e = pmv >> 5; const int b = (pmv >> 1) & 15; half = pmv & 1; g = b * NE + e; }
struct ProbMoeUp {
    static constexpr bool GATHER = true, FP8 = true;
    const unsigned char* A; const unsigned char* Bt; const int* idx; int K; pg8::TileOrder ord;
    DI bool next(int i, Unit& u) const { return ord.next(i, u); }
    DI const void* a_base(const Unit& u) const { return A + fix_h2(((u.pm >> 1) & 15) >> 3); }
    DI const void* b_base(const Unit& u) const { int g, half, e; moe_unit(u.pm, g, half, e); return Bt + ((size_t)e * 2048 + (size_t)u.pn * 256) * K; }
    DI void a_rows(const Unit& u, int tid, unsigned (&pk)[2]) const {
        int g, half, e; moe_unit(u.pm, g, half, e); const int b = g >> 4;
#pragma unroll
        for (int i = 0; i < 2; ++i) { int R, C; pg8::stage_rc(tid * 16 + i * 8192, R, C);
            const int t0 = idx[g * CAP + half * 256 + R], t1 = idx[g * CAP + half * 256 + 128 + R]; pk[i] = (unsigned)(b * SEQ + t0) | ((unsigned)(b * SEQ + t1) << 16); }
    }
};
struct ProbMoeDown {
    static constexpr bool GATHER = false, FP8 = true;
    const unsigned char* A; const unsigned char* Bt; int K; pg8::TileOrder ord;
    DI bool next(int i, Unit& u) const { return ord.next(i, u); }
    DI const void* a_tile(const Unit& u) const { int g, half, e; moe_unit(u.pm, g, half, e); return A + fix_hid(g >> 7) + ((size_t)g * CAP + half * 256) * K; }
    DI const void* b_base(const Unit& u) const { int g, half, e; moe_unit(u.pm, g, half, e); return Bt + ((size_t)e * 1024 + (size_t)u.pn * 256) * K; }
};

DI void store8(bf16_t* p, const f32x4 v0, const f32x4 v1) { u32x4 w; w.x = cvtpk_s(v0[0], v0[1]); w.y = cvtpk_s(v0[2], v0[3]); w.z = cvtpk_s(v1[0], v1[1]); w.w = cvtpk_s(v1[2], v1[3]); *(u32x4*)p = w; }
struct EpiPlanes {
    static constexpr bool PERM = true;
    bf16_t* pl0;
    DI void operator()(const f32x4 (&acc)[2][2][4][2], const Unit& u, int wr, int wc, int fr, int fq) const {
        const int row0 = u.pm * 256 + wr * 64 + fr, col0 = wc * 32 + 8 * fq;
        bf16_t* const pl = pl0 + fix_pl(u.pm >> 7) / 2;
        if (u.pn < 4) {
            bf16_t* base = pl + (size_t)u.pn * (PLANE / 2) + col0;
#pragma unroll
            for (int ai = 0; ai < 2; ++ai)
#pragma unroll
                for (int m = 0; m < 4; ++m) { f32x4 r0, r1;
#pragma unroll
                    for (int j = 0; j < 4; ++j) { r0[j] = acc[ai][0][m][0][j] * sigmoidf_(acc[ai][1][m][0][j]); r1[j] = acc[ai][0][m][1][j] * sigmoidf_(acc[ai][1][m][1][j]); }
                    store8(base + (size_t)(row0 + ai * 128 + m * 16) * 128, r0, r1); }
        } else {
            bf16_t* base = pl + (size_t)(2 * u.pn - 4) * (PLANE / 2) + col0;
#pragma unroll
            for (int ai = 0; ai < 2; ++ai)
#pragma unroll
                for (int m = 0; m < 4; ++m)
#pragma unroll
                    for (int bj = 0; bj < 2; ++bj) store8(base + (size_t)bj * (PLANE / 2) + (size_t)(row0 + ai * 128 + m * 16) * 128, acc[ai][bj][m][0], acc[ai][bj][m][1]);
        }
    }
};
struct EpiCtxPlanes {
    static constexpr bool PERM = true;
    bf16_t* pl;
    DI void operator()(const f32x4 (&acc)[2][2][4][2], const Unit& u, int wr, int wc, int fr, int fq) const {
        const int row0 = u.pm * 256 + wr * 64 + fr, col0 = wc * 32 + 8 * fq;
        bf16_t* base = pl + (size_t)(2 * u.pn) * (CPLANE / 2) + col0;
#pragma unroll
        for (int ai = 0; ai < 2; ++ai)
#pragma unroll
            for (int m = 0; m < 4; ++m)
#pragma unroll
                for (int bj = 0; bj < 2; ++bj) store8(base + (size_t)bj * (CPLANE / 2) + (size_t)(row0 + ai * 128 + m * 16) * 128, acc[ai][bj][m][0], acc[ai][bj][m][1]);
    }
};
struct EpiX1 {
    static constexpr bool PERM = true;
    bf16_t* O; const float* x; const float* mod;
    DI void operator()(const f32x4 (&acc)[2][2][4][2], const Unit& u, int wr, int wc, int fr, int fq) const {
        const int row0 = u.pm * 256 + wr * 64 + fr, col0 = u.pn * 256 + wc * 64 + 8 * fq;
        bf16_t* const Oh = O + fix_mix(u.pm >> 7) / 2;
        const float* const g1p = mod + (size_t)(u.pm >> 4) * MODW + 2 * DM + col0;
        f32x4 g1[2][2];
#pragma unroll
        for (int bj = 0; bj < 2; ++bj) { g1[bj][0] = *(const f32x4*)(g1p + bj * 32); g1[bj][1] = *(const f32x4*)(g1p + bj * 32 + 4); }
#pragma unroll
        for (int ai = 0; ai < 2; ++ai) {
            f32x4 xv[4][2][2];
#pragma unroll
            for (int m = 0; m < 4; ++m)
#pragma unroll
                for (int bj = 0; bj < 2; ++bj) { const float* xp = x + (size_t)(row0 + ai * 128 + m * 16) * DM + col0 + bj * 32; xv[m][bj][0] = *(const f32x4*)xp; xv[m][bj][1] = *(const f32x4*)(xp + 4); }
#pragma unroll
            for (int m = 0; m < 4; ++m)
#pragma unroll
                for (int bj = 0; bj < 2; ++bj) store8(Oh + (size_t)(row0 + ai * 128 + m * 16) * DM + col0 + bj * 32, xv[m][bj][0] + g1[bj][0] * acc[ai][bj][m][0], xv[m][bj][1] + g1[bj][1] * acc[ai][bj][m][1]);
        }
    }
};
constexpr float WSCALE = 32.0f, WINV = 1.0f / 32.0f;
DI unsigned pk4_fp8(float a, float b, float c, float d) { unsigned w = 0; w = __builtin_amdgcn_cvt_pk_fp8_f32(a, b, w, false); w = __builtin_amdgcn_cvt_pk_fp8_f32(c, d, w, true); return w; }
struct EpiSwiglu {
    static constexpr bool PERM = true;
    unsigned char* hid;
    DI void operator()(const f32x4 (&acc)[2][2][4][2], const Unit& u, int wr, int wc, int fr, int fq) const {
        int g, half, e; moe_unit(u.pm, g, half, e);
        const int row0 = g * CAP + half * 256 + wr * 64 + fr, col0 = u.pn * 128 + wc * 32 + 8 * fq;
#pragma unroll
        for (int ai = 0; ai < 2; ++ai)
#pragma unroll
            for (int m = 0; m < 4; ++m) { unsigned char* rowp = hid + fix_hid(g >> 7) + (size_t)(row0 + ai * 128 + m * 16) * FF + col0;
                float r[8];
#pragma unroll
                for (int n = 0; n < 2; ++n)
#pragma unroll
                    for (int j = 0; j < 4; ++j) { const float gt = acc[ai][0][m][n][j] * WINV, up = acc[ai][1][m][n][j] * WINV; r[n * 4 + j] = siluf_(gt) * up; }
                u32x2 w; w.x = pk4_fp8(r[0], r[1], r[2], r[3]); w.y = pk4_fp8(r[4], r[5], r[6], r[7]);
                *(u32x2*)rowp = w; }
    }
};
struct EpiDown {
    static constexpr bool PERM = true;
    bf16_t* O;
    DI void operator()(const f32x4 (&acc)[2][2][4][2], const Unit& u, int wr, int wc, int fr, int fq) const {
        int g, half, e; moe_unit(u.pm, g, half, e);
        const int row0 = g * CAP + half * 256 + wr * 64 + fr, col0 = u.pn * 256 + wc * 64 + 8 * fq;
#pragma unroll
        for (int ai = 0; ai < 2; ++ai)
#pragma unroll
            for (int m = 0; m < 4; ++m) { bf16_t* rowp = O + fix_mout(g >> 7) / 2 + (size_t)(row0 + ai * 128 + m * 16) * DM + col0;
#pragma unroll
                for (int bj = 0; bj < 2; ++bj) store8(rowp + bj * 32, acc[ai][bj][m][0] * WINV, acc[ai][bj][m][1] * WINV); }
    }
};

#define XB_TMO      128
#define XB_XCNT(j)  (256  + 64 * (j))
#define XB_XSUB(j)  (1280 + 64 * (j))
#define XB_XGEN(j)  (2304 + 64 * (j))
#define XB_TOP      3328
#define XB_TOPGEN   3392
#define XCD_BAR_WORDS 3456
#define XB_SPIN_CAP (1u << 18)
DI unsigned xb_ld(unsigned* p)              { return __hip_atomic_load(p, __ATOMIC_RELAXED, __HIP_MEMORY_SCOPE_AGENT); }
DI unsigned xb_add(unsigned* p, unsigned v) { return __hip_atomic_fetch_add(p, v, __ATOMIC_RELAXED, __HIP_MEMORY_SCOPE_AGENT); }
DI unsigned xb_xcc_id() { return (unsigned)__builtin_amdgcn_s_getreg((3 << 11) | 20) & 0xFu; }
#define XB_SPIN(cond, bar) do { unsigned _sp = 0; while (cond) { __builtin_amdgcn_s_sleep(1); \
    if ((++_sp & 255u) == 0u) { if (xb_ld(&(bar)[XB_TMO])) break; if (_sp > XB_SPIN_CAP) { atomicAdd(&(bar)[XB_TMO], 1u); break; } } } } while (0)
struct XcdBarrier { unsigned* bar; unsigned x; volatile LAS unsigned* st; unsigned nwg; };
DI XcdBarrier xcd_barrier_post(unsigned* bar, volatile LAS unsigned* st, bool leader, unsigned nwg) {
    XcdBarrier b; b.bar = bar; b.x = xb_xcc_id(); b.st = st; b.nwg = nwg;
    if (leader) (void)xb_add(&bar[XB_XCNT(b.x)], 1u);
    return b;
}
DI void xcd_barrier_complete(unsigned* bar, unsigned x, unsigned& nloc, unsigned& nx, const unsigned G) {
    unsigned sum, cnt, mine, sp = 0u;
    for (;;) {
        sum = 0u; cnt = 0u; mine = 0u;
#pragma unroll
        for (unsigned j = 0; j < 16; ++j) { const unsigned c = xb_ld(&bar[XB_XCNT(j)]); sum += c; cnt += (c > 0u) ? 1u : 0u; mine = (j == x) ? c : mine; }
        if (sum == G) break;
        __builtin_amdgcn_s_sleep(1);
        if ((++sp & 255u) == 0u) { if (xb_ld(&bar[XB_TMO])) break; if (sp > XB_SPIN_CAP) { atomicAdd(&bar[XB_TMO], 1u); break; } }
    }
    nloc = mine > 0u ? mine : 1u; nx = cnt > 0u ? cnt : 1u;
}
DI void xcd_barrier(const XcdBarrier& b, bool leader) {
    asm volatile("s_waitcnt vmcnt(0)" ::: "memory");
    __syncthreads();
    if (leader) {
        unsigned* bar = b.bar;
        __builtin_amdgcn_s_waitcnt(0);
        unsigned nloc = b.st[0], nx = b.st[1];
        if (nloc == 0u) { xcd_barrier_complete(bar, b.x, nloc, nx, b.nwg); b.st[0] = nloc; b.st[1] = nx; }
        const unsigned old = xb_add(&bar[XB_XSUB(b.x)], 1u);
        const unsigned gen = old / nloc;
        if (old + 1u == (gen + 1u) * nloc) {
            __builtin_amdgcn_fence(__ATOMIC_RELEASE, "agent");
            asm volatile("s_waitcnt vmcnt(0)" ::: "memory");
            const unsigned og = xb_add(&bar[XB_TOP], 1u);
            const unsigned tg = og / nx;
            if (og + 1u == (tg + 1u) * nx) xb_add(&bar[XB_TOPGEN], 1u);
            else XB_SPIN(xb_ld(&bar[XB_TOPGEN]) == tg, bar);
            __builtin_amdgcn_fence(__ATOMIC_ACQUIRE, "agent");
            xb_add(&bar[XB_XGEN(b.x)], 1u);
            asm volatile("s_waitcnt vmcnt(0)" ::: "memory");
        } else {
            XB_SPIN(xb_ld(&bar[XB_XGEN(b.x)]) == gen, bar);
            __builtin_amdgcn_fence(__ATOMIC_ACQUIRE, "agent");
            asm volatile("s_waitcnt vmcnt(0)" ::: "memory");
        }
    }
    __syncthreads();
}

struct Frame { LAS unsigned char* lds; int tid, lane, wave, blk, nblk, b0, nb; };
DI void frame_refresh(Frame& F) { int l; asm volatile("v_mbcnt_lo_u32_b32 %0, -1, 0\n\tv_mbcnt_hi_u32_b32 %0, -1, %0" : "=v"(l)); F.lane = l; F.tid = F.wave * 64 + l; }
typedef const Args __attribute__((address_space(4))) KArgs;
DI KArgs* kargs_fresh() { KArgs* p = (KArgs*)__builtin_amdgcn_kernarg_segment_ptr(); asm volatile("" : "+s"(p)); return p; }
#define WSP(T, A, off) ((T*)((A)->ws + (off)))

DI void transpose_item(const float* W, int K, int N, bf16_t* WT, int k0, int n0, int drow0, LAS float* scr, int lane) {
#pragma unroll
    for (int i = 0; i < 32; ++i) { const int kk = 2 * i + (lane >> 5); scr[kk * 33 + (lane & 31)] = W[(size_t)(k0 + kk) * N + n0 + (lane & 31)]; }
    asm volatile("s_waitcnt lgkmcnt(0)" ::: "memory");
    const int c = lane & 7;
#pragma unroll
    for (int j = 0; j < 4; ++j) { const int n = (lane >> 3) + 8 * j; const LAS float* s = scr + (8 * c) * 33 + n;
        u32x4 o; o.x = pk2(s[0 * 33], s[1 * 33]); o.y = pk2(s[2 * 33], s[3 * 33]); o.z = pk2(s[4 * 33], s[5 * 33]); o.w = pk2(s[6 * 33], s[7 * 33]);
        *(u32x4*)(WT + (size_t)(drow0 + n) * K + k0 + 8 * c) = o; }
    asm volatile("s_waitcnt lgkmcnt(0)" ::: "memory");
}
DI void transpose_item_fp8(const float* W, int K, int N, unsigned char* WT, int k0, int n0, int drow0, LAS float* scr, int lane) {
#pragma unroll
    for (int i = 0; i < 32; ++i) { const int kk = 2 * i + (lane >> 5); scr[kk * 33 + (lane & 31)] = W[(size_t)(k0 + kk) * N + n0 + (lane & 31)]; }
    asm volatile("s_waitcnt lgkmcnt(0)" ::: "memory");
    const int c = lane & 7;
#pragma unroll
    for (int j = 0; j < 4; ++j) { const int n = (lane >> 3) + 8 * j; const LAS float* s = scr + (8 * c) * 33 + n;
        u32x2 o; o.x = pk4_fp8(s[0 * 33] * WSCALE, s[1 * 33] * WSCALE, s[2 * 33] * WSCALE, s[3 * 33] * WSCALE); o.y = pk4_fp8(s[4 * 33] * WSCALE, s[5 * 33] * WSCALE, s[6 * 33] * WSCALE, s[7 * 33] * WSCALE);
        *(u32x2*)(WT + (size_t)(drow0 + n) * K + k0 + 8 * c) = o; }
    asm volatile("s_waitcnt lgkmcnt(0)" ::: "memory");
}
template <int PART>
DI void p0_transposes(Frame& F) {
    KArgs* Ap = kargs_fresh(); KArgs& A = *Ap;
    bf16_t* const win = WSP(bf16_t, Ap, WS_WIN); bf16_t* const wout = WSP(bf16_t, Ap, WS_WOUT); unsigned char* const wgu = WSP(unsigned char, Ap, WS_WGU); unsigned char* const wdn = WSP(unsigned char, Ap, WS_WDN);
    LAS float* scr = (LAS float*)(F.lds + F.wave * 16384);
    const int gw = F.blk * NWAVES + F.wave, ngw = F.nblk * NWAVES;
    constexpr int I_IN = 16 * (INC / 32), I_OUT = 16 * 32, I_E = 16 * 32;
    if constexpr (PART == 0) {
        for (int it = gw; it < I_IN + I_OUT; it += ngw) {
            int r = it;
            if (r < I_IN) { const int nb = r % (INC / 32), kb = r / (INC / 32); const int n0 = nb * 32; const int d0 = n0 < 512 ? ((n0 >> 7) * 256 + (n0 & 127)) : (n0 < 1024 ? (((n0 - 512) >> 7) * 256 + 128 + (n0 & 127)) : n0);
                transpose_item(A.w_in, DM, INC, win, kb * 64, n0, d0, scr, F.lane); continue; } r -= I_IN;
            { const int nb = r % 32, kb = r / 32, n0 = nb * 32; transpose_item(A.w_out, DM, DM, wout, kb * 64, n0, (n0 & ~255) + 128 * ((n0 >> 5) & 1) + 32 * ((n0 & 255) >> 6), scr, F.lane); }
        }
    } else {
        for (int r = gw; r < NE * 3 * I_E; r += ngw) {
            const int e = r / (3 * I_E), q = r % (3 * I_E), which = q / I_E, rr = q % I_E, nb = rr % 32, kb = rr / 32, n0 = nb * 32;
            if (which == 0) transpose_item_fp8(A.w_gate + (size_t)e * DM * FF, DM, FF, wgu + (size_t)e * 2048 * DM, kb * 64, n0, (n0 >> 7) * 256 + (n0 & 127), scr, F.lane);
            else if (which == 1) transpose_item_fp8(A.w_up + (size_t)e * DM * FF, DM, FF, wgu + (size_t)e * 2048 * DM, kb * 64, n0, (n0 >> 7) * 256 + 128 + (n0 & 127), scr, F.lane);
            else transpose_item_fp8(A.w_down + (size_t)e * FF * DM, FF, DM, wdn + (size_t)e * DM * FF, kb * 64, n0, (n0 & ~255) + 128 * ((n0 >> 5) & 1) + 32 * ((n0 & 255) >> 6), scr, F.lane);
        }
    }
}
DI void p0_prologue(Frame& F) {
    KArgs* Ap = kargs_fresh(); KArgs& A = *Ap;
    float* const mod = WSP(float, Ap, WS_MOD); float* const lbo = WSP(float, Ap, WS_LB);
    {
        LAS float* sm = (LAS float*)F.lds;
        for (int i = F.tid; i < 17 * DM; i += NTHR) { const int v = i >> 10, k = i & 1023; const float xv = v < 16 ? A.c[v * DM + k] : A.c_ctx[k]; sm[i] = siluf_(xv); }
        __syncthreads();
        LAS float* red = sm + 17 * DM;
        for (int chunk = F.blk; chunk < MODW / 24; chunk += F.nblk) {
            const int col = F.tid % 24, kg = F.tid / 24;
            float acc[17];
#pragma unroll
            for (int v = 0; v < 17; ++v) acc[v] = 0.f;
            if (kg < 21) {
#pragma unroll 7
                for (int k = kg; k < DM; k += 21) { const float w = A.ada_w[(size_t)k * MODW + chunk * 24 + col];
#pragma unroll
                    for (int v = 0; v < 17; ++v) acc[v] += sm[v * DM + k] * w; }
#pragma unroll
                for (int v = 0; v < 17; ++v) red[(kg * 17 + v) * 24 + col] = acc[v];
            }
            __syncthreads();
            if (F.tid < 17 * 24) { const int v = F.tid / 24, cc = F.tid % 24; float s = A.ada_b[chunk * 24 + cc];
                for (int g = 0; g < 21; ++g) s += red[(g * 17 + v) * 24 + cc];
                mod[v * MODW + chunk * 24 + cc] = s; }
            __syncthreads();
        }
    }
    if (F.blk == 0) for (int i = F.tid; i < 2 * HWID; i += NTHR) { const float l0 = A.lb_logits[i], l1 = A.lb_logits[2 * HWID + i]; lbo[i] = 1.0f / (1.0f + __expf(l1 - l0)); }
}

DI void p1_rows(Frame& F, const int grow0, const int NROW, const int gw, const int ngw) {
    KArgs* Ap = kargs_fresh(); KArgs& A = *Ap; const float* const mod = WSP(float, Ap, WS_MOD); bf16_t* const hout = WSP(bf16_t, Ap, WS_H);
    const int lane = F.lane;
#define P1_GROW(r_) (grow0 + (r_))
    f32x4 raw[4][4];
#define P1_LOAD(r0_) do { const int rr_ = P1_GROW(r0_); const float* src_ = rr_ < MTOK ? A.x + (size_t)rr_ * DM : A.ctx + (size_t)(rr_ - MTOK) * DM; \
        _Pragma("unroll") for (int t = 0; t < 4; ++t) _Pragma("unroll") for (int j = 0; j < 4; ++j) raw[t][j] = *(const f32x4*)(src_ + (size_t)t * DM + 4 * lane + 256 * j); } while (0)
    int r0 = gw * 4;
    if (r0 < NROW) P1_LOAD(r0);
    for (; r0 < NROW; r0 += ngw * 4) {
        const int gr0 = P1_GROW(r0);
        const int v = gr0 < MTOK ? (gr0 >> 12) : 16;
        const float* md = mod + (size_t)v * MODW;
        f32x4 xv[4][4]; float ss[4];
#pragma unroll
        for (int t = 0; t < 4; ++t) { ss[t] = 0.f;
#pragma unroll
            for (int j = 0; j < 4; ++j) { xv[t][j] = raw[t][j]; ss[t] += (xv[t][j].x * xv[t][j].x + xv[t][j].y * xv[t][j].y) + (xv[t][j].z * xv[t][j].z + xv[t][j].w * xv[t][j].w); } }
        if (r0 + ngw * 4 < NROW) P1_LOAD(r0 + ngw * 4);
        f32x4 gs[4], sh[4];
#pragma unroll
        for (int j = 0; j < 4; ++j) { const int col = 4 * lane + 256 * j; gs[j] = *(const f32x4*)(A.norm1_g + col) * (*(const f32x4*)(md + DM + col) + 1.0f); sh[j] = *(const f32x4*)(md + col); }
#pragma unroll
        for (int t = 0; t < 4; ++t) { const float rstd = rsqrtf(wave_sum(ss[t]) * (1.0f / DM) + EPS);
            bf16_t* dst = hout + (size_t)(gr0 + t) * DM;
#pragma unroll
            for (int j = 0; j < 4; ++j) { const f32x4 y = xv[t][j] * rstd * gs[j] + sh[j];
                u32x2 w; w.x = cvtpk_s(y.x, y.y); w.y = cvtpk_s(y.z, y.w); *(u32x2*)(dst + 4 * lane + 256 * j) = w; } }
    }
#undef P1_LOAD
#undef P1_GROW
}

template <int P0, int N> DI void conv_out(const f32x2 (&u)[64], const f32x2 (&tp)[CK], const f32x2 bias, bf16_t* dst, const size_t dstride) {
    if constexpr (N == 1) {
        f32x2 s = bias;
#pragma unroll
        for (int k = 0; k < CK; ++k) { const int q = P0 + k - CPAD; if (q >= 0 && q < 64) s += tp[k] * u[q]; }
        *(unsigned*)(dst + (size_t)P0 * dstride) = pk2(s.x, s.y);
    } else { conv_out<P0, N / 2>(u, tp, bias, dst, dstride); conv_out<P0 + N / 2, N - N / 2>(u, tp, bias, dst, dstride); }
}
DI void conv_item(Frame& F, int item) {
    KArgs* Ap = kargs_fresh(); KArgs& A = *Ap;
    const int lane = F.lane;
    const int nline = F.nb * 64, cg2 = item & 1, line = (item >> 1) % nline, axis = (item >> 1) / nline;
    const int b = F.b0 + (line >> 6), l = line & 63;
    const int cgp = axis * 2 + cg2, ch = cgp * 128 + 2 * lane;
    const int tok0 = b * SEQ + (axis == 0 ? l * GW : l), tstride = (axis == 0 ? 1 : GW);
    const bf16_t* const up = WSP(bf16_t, Ap, WS_PL) + fix_pl(b >> 3) / 2 + (size_t)(PL_U + cgp) * (PLANE / 2) + (size_t)tok0 * 128 + 2 * lane;
    bf16_t* const cp = WSP(bf16_t, Ap, WS_PL) + fix_pl(b >> 3) / 2 + (size_t)(PL_CPRE + cgp) * (PLANE / 2) + (size_t)tok0 * 128 + 2 * lane;
    unsigned raw[64];
#pragma unroll
    for (int p = 0; p < 64; ++p) raw[p] = *(const unsigned*)(up + (size_t)p * tstride * 128);
    asm volatile("" ::: "memory");
    f32x2 u[64];
#pragma unroll
    for (int p = 0; p < 64; ++p) { u[p].x = bflo(raw[p]); u[p].y = bfhi(raw[p]); }
    f32x2 tp[CK];
#pragma unroll
    for (int k = 0; k < CK; ++k) tp[k] = *(const f32x2*)(A.taps + k * CWID + ch);
    const f32x2 bias = *(const f32x2*)(A.conv_bias + ch);
    conv_out<0, 64>(u, tp, bias, cp, (size_t)tstride * 128);
}


template <int DIR, bool ISCTX>
DI f32x2 prep_pass(bf16_t* fcol, bf16_t* qsrc, bf16_t* qdst, const f32x2 lbv) {
    const f32x2 om = {1.0f - lbv.x, 1.0f - lbv.y};
    f32x2 G = {1.0f, 1.0f};
#pragma unroll 1
    for (int grp = 0; grp < 4; ++grp) {
        const int t0 = DIR ? grp * 16 : 48 - grp * 16;
        bf16_t* const fp = fcol + t0 * 128; bf16_t* const qp = qsrc + t0 * 128; bf16_t* const qd = qdst + t0 * 128;
        unsigned xw[16], qw[16];
#pragma unroll
        for (int j = 0; j < 16; ++j) { xw[j] = *(const unsigned*)(fp + j * 128); if (!ISCTX) qw[j] = *(const unsigned*)(qp + j * 128); }
#pragma unroll
        for (int i = 0; i < 16; ++i) {
            const int j = DIR ? i : 15 - i;
            f32x2 f; f.x = lbv.x + om.x * sigmoidf_(bflo(xw[j])); f.y = lbv.y + om.y * sigmoidf_(bfhi(xw[j]));
            *(unsigned*)(fp + j * 128) = cvtpk_s((1.0f - f.x) * G.x, (1.0f - f.y) * G.y);
            if (!ISCTX) {
                const float gx = __builtin_amdgcn_rcpf(fmaxf(G.x, 1e-30f)), gy = __builtin_amdgcn_rcpf(fmaxf(G.y, 1e-30f));
                *(unsigned*)(qd + j * 128) = cvtpk_s(bflo(qw[j]) * gx, bfhi(qw[j]) * gy);
            }
            G.x *= f.x; G.y *= f.y;
        }
    }
    return G;
}
DI void prep_item(Frame& F, int item) {
    KArgs* Ap = kargs_fresh(); const float* const lb = WSP(float, Ap, WS_LB); float* const earr = WSP(float, Ap, WS_EARR);
    const int lane = F.lane;
    if (item < F.nb * 64 * NH) {
        const int hh = item & 3, c = (item >> 2) & 63, b = F.b0 + (item >> 8), kc = hh * HD + 2 * lane;
        bf16_t* const t0 = WSP(bf16_t, Ap, WS_PL) + fix_pl(b >> 3) / 2 + (size_t)hh * (PLANE / 2) + (size_t)(b * SEQ + c * 64) * 128 + 2 * lane;
        float* const e0 = earr + ((size_t)((b * NH + hh) * 2) * NCHK + 4) * HD + 2 * lane;
        const f32x2 Gb = prep_pass<1, false>(t0 + (size_t)PL_FB * (PLANE / 2), t0 + (size_t)PL_Q * (PLANE / 2), t0 + (size_t)PL_QB * (PLANE / 2), *(const f32x2*)(lb + HWID + kc));
        *(f32x2*)(e0 + (size_t)(NCHK + (63 - c)) * HD) = Gb;
        const f32x2 Gf = prep_pass<0, false>(t0 + (size_t)PL_FF * (PLANE / 2), t0 + (size_t)PL_Q * (PLANE / 2), t0 + (size_t)PL_Q * (PLANE / 2), *(const f32x2*)(lb + kc));
        *(f32x2*)(e0 + (size_t)c * HD) = Gf;
    } else {
        const int it = item - F.nb * 64 * NH, hh = it & 3, c = (it >> 2) & 3, b = F.b0 + (it >> 4), kc = hh * HD + 2 * lane;
        bf16_t* const t0 = WSP(bf16_t, Ap, WS_PCTX) + (size_t)hh * (CPLANE / 2) + (size_t)(b * CTXL + c * 64) * 128 + 2 * lane;
        float* const e0 = earr + ((size_t)((b * NH + hh) * 2) * NCHK) * HD + 2 * lane;
        const f32x2 Gb = prep_pass<1, true>(t0 + (size_t)8 * (CPLANE / 2), t0, t0, *(const f32x2*)(lb + HWID + kc));
        *(f32x2*)(e0 + (size_t)(NCHK + (3 - c)) * HD) = Gb;
        const f32x2 Gf = prep_pass<0, true>(t0 + (size_t)4 * (CPLANE / 2), t0, t0, *(const f32x2*)(lb + kc));
        *(f32x2*)(e0 + (size_t)c * HD) = Gf;
    }
}

typedef short s16x4 __attribute__((ext_vector_type(4)));
DI s16x4 vtr(LAS const unsigned char* p) { return __builtin_bit_cast(s16x4, __builtin_amdgcn_ds_read_tr16_b64_v4i16((LAS s16x4*)p)); }
constexpr int SC_BUF = 41984, SC_Q = 0, SC_K = 16384, SC_V = 32768, SC_E = 40960, SC_P = 3 * SC_BUF, SC_PSTR = 144, SC_O = SC_P + 64 * SC_PSTR, SC_OSTR = 144;
static_assert(SC_O + 64 * SC_OSTR <= MISC_OFF, "scan LDS map");
DI int swV(int row) { return (((row >> 1) & 1) << 1) | (((row >> 3) & 1) << 2); }
DI int swK(int row) { return (row & 7) << 1; }
DI int swQ(int row) { return row & 15; }
DI int tile_off(int row, int colbyte, int sw) { return row * 256 + ((((colbyte >> 4) ^ sw)) << 4) + (colbyte & 15); }
#define SC_BAR() do { asm volatile("s_waitcnt lgkmcnt(0)" ::: "memory"); __builtin_amdgcn_s_barrier(); asm volatile("" ::: "memory"); } while (0)
DI constexpr int pt_tt(int W, int t) { return W == 0 ? 3 : W == 1 ? (t == 0 ? 3 : 2) : W == 2 ? (t == 0 ? 2 : 1) : 0; }
DI constexpr int pt_st(int W, int t) { return W == 0 ? t : W == 1 ? (t == 0 ? 3 : t - 1) : W == 2 ? (t == 0 ? 2 : t - 1) : 0; }
template <int W> DI void scan_ptiles(LAS unsigned char* lds, const int kb, const int qb, const int pb, const int l15, const int g) {
    constexpr int NT = W == 3 ? 1 : 3;
    int ka[4], qa[4];
#pragma unroll
    for (int ks = 0; ks < 4; ++ks) { ka[ks] = kb ^ (ks << 6); qa[ks] = qb ^ (ks << 6); }
    bf16x8 a[NT][4], bq[NT][4];
#pragma unroll
    for (int t = 0; t < NT; ++t) {
        const bool newq = (t == 0) || pt_tt(W, t) != pt_tt(W, t - 1);
#pragma unroll
        for (int ks = 0; ks < 4; ++ks) {
            a[t][ks] = *(const LAS bf16x8*)(lds + ka[ks] + pt_st(W, t) * 4096);
            if (newq) bq[t][ks] = *(const LAS bf16x8*)(lds + qa[ks] + pt_tt(W, t) * 4096); else bq[t][ks] = bq[t - 1][ks];
        }
    }
    f32x4 acc[NT];
#pragma unroll
    for (int t = 0; t < NT; ++t) acc[t] = (f32x4){0.f, 0.f, 0.f, 0.f};
#pragma unroll
    for (int ks = 0; ks < 4; ++ks)
#pragma unroll
        for (int t = 0; t < NT; ++t) acc[t] = __builtin_amdgcn_mfma_f32_16x16x32_bf16(a[t][ks], bq[t][ks], acc[t], 0, 0, 0);
#pragma unroll
    for (int t = 0; t < NT; ++t) {
        float pv[4];
#pragma unroll
        for (int r = 0; r < 4; ++r) pv[r] = (pt_tt(W, t) != pt_st(W, t) || 4 * g + r <= l15) ? acc[t][r] : 0.f;
        u32x2 pw; pw.x = cvtpk_s(pv[0], pv[1]); pw.y = cvtpk_s(pv[2], pv[3]);
        *(LAS u32x2*)(lds + pb + pt_tt(W, t) * 16 * SC_PSTR + pt_st(W, t) * 32) = pw;
    }
}
DI void scan_item(Frame& F, int item) {
    const int half = item & 1, dir = (item >> 1) & 1, hh = (item >> 2) & 3, b = F.b0 + (item >> 4), stream = (b * NH + hh) * 2 + dir;
    const int tid = F.tid, lane = F.lane, w = F.wave, l15_ = lane & 15, g_ = lane >> 4;
    KArgs* Ap = kargs_fresh();
    LAS unsigned char* const lds = F.lds;
    const unsigned char* const plb = (const unsigned char*)WSP(bf16_t, Ap, WS_PL) + fix_pl(b >> 3) + (size_t)hh * PLANE + (size_t)b * SEQ * 256;
    const unsigned char* const pcb = (const unsigned char*)WSP(bf16_t, Ap, WS_PCTX) + (size_t)hh * CPLANE + (size_t)b * CTXL * 256;
    const unsigned char* const earrb = (const unsigned char*)(WSP(float, Ap, WS_EARR) + (size_t)stream * NCHK * HD);
    bf16_t* const obase = WSP(bf16_t, Ap, WS_PL) + fix_pl(b >> 3) / 2 + (size_t)((dir ? PL_OB : PL_OF) + hh) * (PLANE / 2) + (size_t)b * SEQ * 128 + 64 * half;
    const int vcol = 64 * half + 16 * (w & 3);
    for (int i = tid; i < 64 * SC_PSTR / 4; i += NTHR) *(LAS unsigned*)(lds + SC_P + 4 * i) = 0u;
    f32x4 S[8];
#pragma unroll
    for (int i = 0; i < 8; ++i) S[i] = (f32x4){0.f, 0.f, 0.f, 0.f};
#define SC_DMA(ci_, bi_) do { const int ci__ = (ci_); const int bo_ = (bi_) * SC_BUF; const bool cx = ci__ < 4; const int c64 = (cx ? ci__ : ci__ - 4) * 64; const int pw_ = w - 4; \
        const unsigned char* rb = cx ? pcb : plb; const int nrow = cx ? CTXL : SEQ; \
        const size_t koff = cx ? (size_t)(dir ? 8 : 4) * CPLANE : (size_t)(dir ? PL_FB : PL_FF) * PLANE, voff = cx ? 0 : (size_t)PL_I * PLANE, qoff = cx ? koff : (size_t)(dir ? PL_QB : PL_Q) * PLANE; \
        _Pragma("unroll") for (int pc = 0; pc < 4; ++pc) { const int inst = 4 * pw_ + pc, row = inst * 4 + g_; const int pos = c64 + row, n = dir ? (nrow - 1 - pos) : pos; \
            const unsigned char* rp = rb + (size_t)n * 256; \
            __builtin_amdgcn_global_load_lds((const unsigned*)(rp + qoff + ((l15_ ^ swQ(row)) << 4)), (LAS unsigned*)(lds + bo_ + SC_Q + inst * 1024), 16, 0, 0); \
            __builtin_amdgcn_global_load_lds((const unsigned*)(rp + koff + ((l15_ ^ swK(row)) << 4)), (LAS unsigned*)(lds + bo_ + SC_K + inst * 1024), 16, 0, 0); } \
        _Pragma("unroll") for (int pc = 0; pc < 2; ++pc) { const int vi = 2 * pw_ + pc, row = vi * 8 + (lane >> 3), pos = c64 + row, n = dir ? (nrow - 1 - pos) : pos; \
          __builtin_amdgcn_global_load_lds((const unsigned*)(rb + (size_t)n * 256 + voff + 128 * half + (((lane & 7) ^ swV(row)) << 4)), (LAS unsigned*)(lds + bo_ + SC_V + vi * 1024), 16, 0, 0); } \
        __builtin_amdgcn_global_load_lds((const unsigned*)(earrb + (size_t)ci__ * (HD * 4) + ((lane & 31) << 4)), (LAS unsigned*)(lds + bo_ + SC_E), 16, 0, 0); \
    } while (0)
    if (w >= 4) { SC_DMA(0, 0); SC_DMA(1, 1); }
    int bi = 0;
    for (int ci = 0; ci < NCHK; ++ci) {
        int l15 = l15_, g = g_;
        asm volatile("" : "+v"(l15), "+v"(g));
        if (w >= 4) { if (ci + 2 < NCHK) asm volatile("s_waitcnt vmcnt(11)" ::: "memory"); else asm volatile("s_waitcnt vmcnt(0)" ::: "memory"); }
        SC_BAR();
        if (w >= 4 && ci + 2 < NCHK) { const int b2 = bi == 0 ? 2 : bi - 1; SC_DMA(ci + 2, b2); }
        const bool lat = ci >= 4;
        const int bo = bi * SC_BUF;
        bi = bi == 2 ? 0 : bi + 1;
        if (w < 4 && ci >= 5) {
#pragma unroll
            for (int k = 0; k < 2; ++k) { const int row = (tid >> 3) + 32 * k, ch = tid & 7, pos = (ci - 5) * 64 + row, n = dir ? (SEQ - 1 - pos) : pos;
                *(u32x4*)(obase + (size_t)n * 128 + ch * 8) = *(const LAS u32x4*)(lds + SC_O + row * SC_OSTR + ch * 16); }
        }
        f32x4 OT[4]; bf16x8 vf[2], kq[3][2]; int kvb = 0;
        if (w >= 4) {
            if (lat) {
                const int kb = bo + SC_K + l15 * 256 + ((g ^ ((l15 & 7) << 1)) << 4), qb = bo + SC_Q + l15 * 256 + ((g ^ l15) << 4), pb = SC_P + l15 * SC_PSTR + 8 * g;
                if (w == 4) scan_ptiles<0>(lds, kb, qb, pb, l15, g); else if (w == 5) scan_ptiles<1>(lds, kb, qb, pb, l15, g); else if (w == 6) scan_ptiles<2>(lds, kb, qb, pb, l15, g); else scan_ptiles<3>(lds, kb, qb, pb, l15, g);
            }
        } else {
            const LAS float* Ev = (const LAS float*)(lds + bo + SC_E);
#pragma unroll
            for (int i = 0; i < 8; ++i) S[i] = S[i] * *(const LAS f32x4*)(Ev + 16 * i + 4 * g);
            if (lat) {
                bf16x8 sa[4];
#pragma unroll
                for (int i2 = 0; i2 < 4; ++i2) { u32x4 pk; pk.x = cvtpk_s(S[2 * i2][0], S[2 * i2][1]); pk.y = cvtpk_s(S[2 * i2][2], S[2 * i2][3]); pk.z = cvtpk_s(S[2 * i2 + 1][0], S[2 * i2 + 1][1]); pk.w = cvtpk_s(S[2 * i2 + 1][2], S[2 * i2 + 1][3]);
                    sa[i2] = __builtin_bit_cast(bf16x8, pk); }
#pragma unroll
                for (int j = 0; j < 4; ++j) OT[j] = (f32x4){0.f, 0.f, 0.f, 0.f};
                bf16x8 qf[2][4];
                const int qv = bo + SC_Q + l15 * 256 + ((((g >> 1) ^ l15)) << 4) + 8 * (g & 1);
#define SC_LDQ(dst, i2_) do { const int qlo_ = qv ^ ((4 * (i2_)) << 4), qhi_ = qv ^ ((4 * (i2_) + 2) << 4); _Pragma("unroll") for (int j = 0; j < 4; ++j) { \
                    const u32x2 lo = *(const LAS u32x2*)(lds + qlo_ + j * 4096), hi = *(const LAS u32x2*)(lds + qhi_ + j * 4096); \
                    u32x4 bb; bb.x = lo.x; bb.y = lo.y; bb.z = hi.x; bb.w = hi.y; dst[j] = __builtin_bit_cast(bf16x8, bb); } } while (0)
                SC_LDQ(qf[0], 0);
#pragma unroll
                for (int i2 = 0; i2 < 4; ++i2) {
                    if (i2 + 1 < 4) SC_LDQ(qf[(i2 + 1) & 1], i2 + 1);
#pragma unroll
                    for (int j = 0; j < 4; ++j) OT[j] = __builtin_amdgcn_mfma_f32_16x16x32_bf16(sa[i2], qf[i2 & 1][j], OT[j], 0, 0, 0);
                }
#undef SC_LDQ
            }
            {
                const int qq = l15 >> 2, pp = l15 & 3;
                const int cb = 32 * (w & 3) + 8 * pp;
                const int vv = bo + SC_V + (8 * g + qq) * 128 + ((((cb >> 4) ^ swV(8 * g + qq))) << 4) + (cb & 15);
#pragma unroll
                for (int ks = 0; ks < 2; ++ks) { const s16x4 lo = vtr(lds + vv + ks * 4096), hi = vtr(lds + vv + ks * 4096 + 512);
                    vf[ks] = __builtin_shufflevector(lo, hi, 0, 1, 2, 3, 4, 5, 6, 7); }
                kvb = bo + SC_K + g * 2048 + qq * 256 + ((((pp >> 1) ^ (2 * qq))) << 4) + 8 * (pp & 1);
#define SC_LDK(dst, i_) do { const int k0_ = kvb ^ ((i_) << 5), k1_ = kvb ^ ((((i_) ^ 4)) << 5); _Pragma("unroll") for (int ks = 0; ks < 2; ++ks) { \
                    const s16x4 lo = vtr(lds + k0_ + ks * 8192), hi = vtr(lds + k1_ + ks * 8192 + 1024); \
                    dst[ks] = __builtin_shufflevector(lo, hi, 0, 1, 2, 3, 4, 5, 6, 7); } } while (0)
                SC_LDK(kq[0], 0); SC_LDK(kq[1], 1); SC_LDK(kq[2], 2);
            }
        }
        SC_BAR();
        if (w < 4) {
            if (lat) {
                bf16x8 pb[4][2];
#pragma unroll
                for (int j = 0; j < 4; ++j)
#pragma unroll
                    for (int ks = 0; ks < 2; ++ks) { if (32 * ks > 16 * j + 15) continue; pb[j][ks] = *(const LAS bf16x8*)(lds + SC_P + (16 * j + l15) * SC_PSTR + (32 * ks + 8 * g) * 2); }
#pragma unroll
                for (int j = 0; j < 4; ++j) {
#pragma unroll
                    for (int ks = 0; ks < 2; ++ks) { if (32 * ks > 16 * j + 15) continue; OT[j] = __builtin_amdgcn_mfma_f32_16x16x32_bf16(vf[ks], pb[j][ks], OT[j], 0, 0, 0); }
                    u32x2 ow; ow.x = cvtpk_s(OT[j][0], OT[j][1]); ow.y = cvtpk_s(OT[j][2], OT[j][3]);
                    *(LAS u32x2*)(lds + SC_O + (16 * j + l15) * SC_OSTR + (16 * (w & 3) + 4 * g) * 2) = ow;
                }
            }
            {
                const int qq = l15 >> 2, pp = l15 & 3;
#pragma unroll
                for (int i = 0; i < 8; ++i) {
                    S[i] = __builtin_amdgcn_mfma_f32_16x16x32_bf16(kq[i % 3][0], vf[0], S[i], 0, 0, 0);
                    S[i] = __builtin_amdgcn_mfma_f32_16x16x32_bf16(kq[i % 3][1], vf[1], S[i], 0, 0, 0);
                    if (i + 3 < 8) SC_LDK(kq[i % 3], i + 3);
                }
            }
#undef SC_LDK
        }
    }
    SC_BAR();
    if (w < 4) {
#pragma unroll
        for (int k = 0; k < 2; ++k) { const int row = (tid >> 3) + 32 * k, ch = tid & 7, pos = (NCHK - 5) * 64 + row, n = dir ? (SEQ - 1 - pos) : pos;
            *(u32x4*)(obase + (size_t)n * 128 + ch * 8) = *(const LAS u32x4*)(lds + SC_O + row * SC_OSTR + ch * 16); }
    }
    asm volatile("s_waitcnt vmcnt(0)" ::: "memory");
    SC_BAR();
#undef SC_DMA
}

DI void p4_mixed(Frame& F, const int tbeg, const int tend, const int gw, const int ngw) {
    KArgs* Ap = kargs_fresh(); KArgs& A = *Ap;
    bf16_t* const mixed = WSP(bf16_t, Ap, WS_H);
    const int lane = F.lane;
    const bf16_t* const plq = WSP(bf16_t, Ap, WS_PL) + fix_pl(tbeg >> 15) / 2 + (size_t)(lane >> 4) * (PLANE / 2) + (lane & 15) * 8;
    float lng[8], lnb[8], hg[8];
    { const f32x4 a0 = *(const f32x4*)(A.ln_g + 8 * lane), a1 = *(const f32x4*)(A.ln_g + 8 * lane + 4), b0 = *(const f32x4*)(A.ln_b + 8 * lane), b1 = *(const f32x4*)(A.ln_b + 8 * lane + 4), c0 = *(const f32x4*)(A.hgrn_g + 8 * lane), c1 = *(const f32x4*)(A.hgrn_g + 8 * lane + 4);
#pragma unroll
      for (int j = 0; j < 4; ++j) { lng[j] = a0[j]; lng[4 + j] = a1[j]; lnb[j] = b0[j]; lnb[4 + j] = b1[j]; hg[j] = c0[j]; hg[4 + j] = c1[j]; } }
    u32x4 rc[4], rf[4], rb[4], rg[4];
#define P5_LOAD(t0_) do { _Pragma("unroll") for (int t = 0; t < 4; ++t) { const size_t ro = (size_t)((t0_) + t) * 128; \
        rc[t] = *(const u32x4*)(plq + (size_t)PL_CPRE * (PLANE / 2) + ro); rf[t] = *(const u32x4*)(plq + (size_t)PL_OF * (PLANE / 2) + ro); \
        rb[t] = *(const u32x4*)(plq + (size_t)PL_OB * (PLANE / 2) + ro); rg[t] = *(const u32x4*)(plq + (size_t)PL_G * (PLANE / 2) + ro); } } while (0)
    if (tbeg + gw * 4 < tend) P5_LOAD(tbeg + gw * 4);
    for (int t0 = tbeg + gw * 4; t0 < tend; t0 += ngw * 4) {
        u32x4 cw[4], fw[4], bw[4], gw4[4];
#pragma unroll
        for (int t = 0; t < 4; ++t) { cw[t] = rc[t]; fw[t] = rf[t]; bw[t] = rb[t]; gw4[t] = rg[t]; }
        if (t0 + ngw * 4 < tend) P5_LOAD(t0 + ngw * 4);
#pragma unroll
        for (int t = 0; t < 4; ++t) {
            float cv[8] = {bflo(cw[t].x), bfhi(cw[t].x), bflo(cw[t].y), bfhi(cw[t].y), bflo(cw[t].z), bfhi(cw[t].z), bflo(cw[t].w), bfhi(cw[t].w)};
            float sm = 0.f;
#pragma unroll
            for (int j = 0; j < 8; ++j) sm += cv[j];
            const float mu = wave_sum(sm) * (1.0f / CWID); float q = 0.f;
#pragma unroll
            for (int j = 0; j < 8; ++j) { cv[j] -= mu; q += cv[j] * cv[j]; }
            const float rstd = rsqrtf(wave_sum(q) * (1.0f / CWID) + EPS);
            float r[8];
#pragma unroll
            for (int j = 0; j < 8; ++j) r[j] = siluf_(cv[j] * rstd * lng[j] + lnb[j]);
            u32x4 w; w.x = cvtpk_s(r[0], r[1]); w.y = cvtpk_s(r[2], r[3]); w.z = cvtpk_s(r[4], r[5]); w.w = cvtpk_s(r[6], r[7]);
            *(u32x4*)(mixed + (size_t)(t0 + t) * DM + 8 * lane) = w;
            const float o[8] = {bflo(fw[t].x) + bflo(bw[t].x), bfhi(fw[t].x) + bfhi(bw[t].x), bflo(fw[t].y) + bflo(bw[t].y), bfhi(fw[t].y) + bfhi(bw[t].y), bflo(fw[t].z) + bflo(bw[t].z), bfhi(fw[t].z) + bfhi(bw[t].z), bflo(fw[t].w) + bflo(bw[t].w), bfhi(fw[t].w) + bfhi(bw[t].w)};
            const float gt[8] = {bflo(gw4[t].x), bfhi(gw4[t].x), bflo(gw4[t].y), bfhi(gw4[t].y), bflo(gw4[t].z), bfhi(gw4[t].z), bflo(gw4[t].w), bfhi(gw4[t].w)};
            float ss = 0.f;
#pragma unroll
            for (int j = 0; j < 8; ++j) ss += o[j] * o[j];
            ss += __shfl_xor(ss, 1); ss += __shfl_xor(ss, 2); ss += __shfl_xor(ss, 4); ss += __shfl_xor(ss, 8);
            const float rs = rsqrtf(ss * (1.0f / HD) + EPS);
#pragma unroll
            for (int j = 0; j < 8; ++j) r[j] = o[j] * rs * hg[j] * siluf_(gt[j]);
            w.x = cvtpk_s(r[0], r[1]); w.y = cvtpk_s(r[2], r[3]); w.z = cvtpk_s(r[4], r[5]); w.w = cvtpk_s(r[6], r[7]);
            *(u32x4*)(mixed + (size_t)(t0 + t) * DM + CWID + 8 * lane) = w;
        }
    }
#undef P5_LOAD
}

DI void p6_rows(Frame& F) {
    KArgs* Ap = kargs_fresh(); KArgs& A = *Ap; const float* const mod = WSP(float, Ap, WS_MOD); unsigned char* const h20 = WSP(unsigned char, Ap, WS_H2); float* const probs = WSP(float, Ap, WS_PROBS); const bf16_t* const mix0 = WSP(bf16_t, Ap, WS_MIX);
    const int lane = F.lane, tid = F.tid;
    LAS float* rw = (LAS float*)F.lds;
    LAS float* ps = (LAS float*)(F.lds + 65536);
    for (int i = tid; i < DM * NE / 4; i += NTHR) { const int col = i >> 2, e4 = i & 3, l = (col & 255) >> 2, cc = col & 3, j = col >> 8;
        *(LAS f32x4*)(rw + ((((j * 4 + cc) * 4 + e4) * 64 + l) << 2)) = *(const f32x4*)(A.router + 4 * i); }
    __syncthreads();
    for (int tile = F.b0 * 16 + F.blk; tile < (F.b0 + F.nb) * 16; tile += F.nblk) {
        const int b = tile >> 4; const float* md = mod + (size_t)b * MODW;
        unsigned char* const h2 = h20 + fix_h2(tile >> 7); const bf16_t* const mix = mix0 + fix_mix(tile >> 7) / 2;
        f32x4 gg[4], sh[4];
#pragma unroll
        for (int j = 0; j < 4; ++j) { const int col = 4 * lane + 256 * j; gg[j] = *(const f32x4*)(A.norm2_g + col) * (*(const f32x4*)(md + 4 * DM + col) + 1.0f); sh[j] = *(const f32x4*)(md + 3 * DM + col); }
        u32x2 mr[2][4];
#define P6_LOAD(it_) do { const int tk_ = tile * 256 + (it_) * 16 + F.wave * 2; _Pragma("unroll") for (int t = 0; t < 2; ++t) _Pragma("unroll") for (int j = 0; j < 4; ++j) { \
            const size_t eo = (size_t)(tk_ + t) * DM + 4 * lane + 256 * j; mr[t][j] = *(const u32x2*)(mix + eo); } } while (0)
        P6_LOAD(0);
#pragma unroll 1
        for (int it = 0; it < 16; ++it) {
            const int tl = it * 16 + F.wave * 2, tok0 = tile * 256 + tl;
            f32x4 y[2][4]; float ss[2];
#pragma unroll
            for (int t = 0; t < 2; ++t) { ss[t] = 0.f;
#pragma unroll
                for (int j = 0; j < 4; ++j) { const f32x4 mv = {bflo(mr[t][j].x), bfhi(mr[t][j].x), bflo(mr[t][j].y), bfhi(mr[t][j].y)};
                    y[t][j] = mv; ss[t] += (y[t][j].x * y[t][j].x + y[t][j].y * y[t][j].y) + (y[t][j].z * y[t][j].z + y[t][j].w * y[t][j].w); } }
            if (it + 1 < 16) P6_LOAD(it + 1);
#pragma unroll
            for (int t = 0; t < 2; ++t) { const float rstd = rsqrtf(wave_sum(ss[t]) * (1.0f / DM) + EPS);
#pragma unroll
                for (int j = 0; j < 4; ++j) { y[t][j] = y[t][j] * rstd * gg[j] + sh[j];
                    *(unsigned*)(h2 + (size_t)(tok0 + t) * DM + 4 * lane + 256 * j) = pk4_fp8(y[t][j].x, y[t][j].y, y[t][j].z, y[t][j].w); } }
            float lg[32];
#pragma unroll
            for (int i = 0; i < 32; ++i) lg[i] = 0.f;
#pragma unroll
            for (int j = 0; j < 4; ++j)
#pragma unroll
                for (int cc = 0; cc < 4; ++cc) {
                    f32x4 r4[4];
#pragma unroll
                    for (int e4 = 0; e4 < 4; ++e4) r4[e4] = *(const LAS f32x4*)(rw + ((((j * 4 + cc) * 4 + e4) * 64 + lane) << 2));
#pragma unroll
                    for (int t = 0; t < 2; ++t)
#pragma unroll
                        for (int e4 = 0; e4 < 4; ++e4)
#pragma unroll
                            for (int q = 0; q < 4; ++q) lg[t * 16 + e4 * 4 + q] += y[t][j][cc] * r4[e4][q];
                }
#define P6_BFLY(off, lb) do { const bool up = (lane & (lb)) != 0; _Pragma("unroll") for (int i = 0; i < (off); ++i) { const float keep = up ? lg[i + (off)] : lg[i], send = up ? lg[i] : lg[i + (off)]; lg[i] = keep + __shfl_xor(send, (lb)); } } while (0)
            P6_BFLY(16, 32); P6_BFLY(8, 16); P6_BFLY(4, 8); P6_BFLY(2, 4); P6_BFLY(1, 2);
#undef P6_BFLY
            float v = lg[0] + __shfl_xor(lg[0], 1), mx = v;
#pragma unroll
            for (int o = 2; o < 32; o <<= 1) mx = fmaxf(mx, __shfl_xor(mx, o));
            const float ev = __expf(v - mx); float den = ev;
#pragma unroll
            for (int o = 2; o < 32; o <<= 1) den += __shfl_xor(den, o);
            if (!(lane & 1)) ps[((lane >> 1) & 15) * 256 + tl + (lane >> 5)] = ev * __builtin_amdgcn_rcpf(den);
        }
#undef P6_LOAD
        __syncthreads();
        { const int n0 = (tile & 15) * 256;
#pragma unroll
          for (int k = 0; k < 2; ++k) { const int i = tid + NTHR * k, e = i >> 6, c4 = (i & 63) * 4;
              *(f32x4*)(probs + ((size_t)(b * NE + e)) * SEQ + n0 + c4) = *(const LAS f32x4*)(ps + e * 256 + c4); } }
        __syncthreads();
    }
}

DI void topk_item(Frame& F, int g) {
    const int tid = F.tid, lane = F.lane, wave = F.wave;
    LAS int* hist = (LAS int*)F.lds; LAS int* scan = hist + 256; LAS int* misc = scan + 256;
    KArgs* Ap = kargs_fresh(); int* const idx = WSP(int, Ap, WS_IDX); float* const gate = WSP(float, Ap, WS_GATE); int* const sel = WSP(int, Ap, WS_SEL);
    const float* pr = WSP(float, Ap, WS_PROBS) + (size_t)g * SEQ + tid * 8;
    const u32x4 p0 = *(const u32x4*)pr, p1 = *(const u32x4*)(pr + 4);
    const unsigned u[8] = {p0.x, p0.y, p0.z, p0.w, p1.x, p1.y, p1.z, p1.w};
    unsigned prefix = 0; int need = CAP;
    for (int pass = 0; pass < 4; ++pass) {
        const int shift = 24 - 8 * pass;
        __syncthreads();
        if (tid < 256) hist[tid] = 0;
        __syncthreads();
#pragma unroll
        for (int j = 0; j < 8; ++j) { const bool match = (pass == 0) || ((u[j] >> (shift + 8)) == prefix);
            if (match) __hip_atomic_fetch_add(hist + ((u[j] >> shift) & 255u), 1, __ATOMIC_RELAXED, __HIP_MEMORY_SCOPE_WORKGROUP); }
        __syncthreads();
        if (wave == 0) {
            const int h0 = hist[4 * lane], h1 = hist[4 * lane + 1], h2 = hist[4 * lane + 2], h3 = hist[4 * lane + 3];
            const int s3 = h3, s2 = h2 + s3, s1 = h1 + s2, s0 = h0 + s1;
            int inc = s0;
#pragma unroll
            for (int o = 1; o < 64; o <<= 1) { const int t = __shfl_down(inc, o); if (lane + o < 64) inc += t; }
            const int above = inc - s0;
            scan[4 * lane] = s0 + above; scan[4 * lane + 1] = s1 + above; scan[4 * lane + 2] = s2 + above; scan[4 * lane + 3] = s3 + above;
        }
        __syncthreads();
        if (tid < 256) { const int incl = scan[tid], above = (tid < 255) ? scan[tid + 1] : 0; if (incl >= need && above < need) { misc[0] = tid; misc[1] = above; } }
        __syncthreads();
        prefix = (prefix << 8) | (unsigned)misc[0]; need -= misc[1];
    }
    const unsigned T = prefix;
    int cg = 0, ce = 0;
#pragma unroll
    for (int j = 0; j < 8; ++j) { cg += (u[j] > T); ce += (u[j] == T); }
    int pk = cg | (ce << 16), inc = pk;
#pragma unroll
    for (int o = 1; o < 64; o <<= 1) { const int t = __shfl_up(inc, o); if (lane >= o) inc += t; }
    __syncthreads();
    if (lane == 63) misc[8 + wave] = inc;
    __syncthreads();
    int base = 0;
#pragma unroll
    for (int w = 0; w < NWAVES; ++w) if (w < wave) base += misc[8 + w];
    const int excl = base + inc - pk; int rg = excl & 0xffff, re = excl >> 16;
    const int cgt = CAP - need;
    const int b = g >> 4, e = g & 15;
#pragma unroll
    for (int j = 0; j < 8; ++j) { const int n = tid * 8 + j; int slot = -1;
        if (u[j] > T) { slot = rg; ++rg; } else if (u[j] == T) { if (re < need) slot = cgt + re; ++re; }
        if (slot >= 0) { idx[g * CAP + slot] = n; gate[g * CAP + slot] = __uint_as_float(u[j]); }
        sel[((size_t)(b * SEQ + n)) * NE + e] = slot; }
}

DI void p10_final(Frame& F) {
    KArgs* Ap = kargs_fresh(); KArgs& A = *Ap; const float* const mod = WSP(float, Ap, WS_MOD); const int* const sel = WSP(int, Ap, WS_SEL); const bf16_t* const mout0 = WSP(bf16_t, Ap, WS_MOUT); const bf16_t* const mix0 = WSP(bf16_t, Ap, WS_MIX); const float* const gate = WSP(float, Ap, WS_GATE);
    const int gw = F.blk * NWAVES + F.wave, ngw = F.nblk * NWAVES, lane = F.lane;
    const int tbeg = F.b0 * SEQ, tend = (F.b0 + F.nb) * SEQ;
    int svn = (tbeg + gw < tend && lane < NE) ? sel[(size_t)(tbeg + gw) * NE + lane] : -1;
    for (int tok = tbeg + gw; tok < tend; tok += ngw) {
        const int b = tok >> 12; const float* md = mod + (size_t)b * MODW + 5 * DM;
        const bf16_t* const mout = mout0 + fix_mout(b >> 3) / 2; const bf16_t* const mix = mix0 + fix_mix(b >> 3) / 2;
        const int sv = svn;
        if (tok + ngw < tend) svn = (lane < NE) ? sel[(size_t)(tok + ngw) * NE + lane] : -1;
        float* xr = A.out + (size_t)tok * DM;
        u32x4 mw2[2];
#pragma unroll
        for (int hlf = 0; hlf < 2; ++hlf) mw2[hlf] = *(const u32x4*)(mix + (size_t)tok * DM + hlf * 512 + 8 * lane);
        float y[16];
#pragma unroll
        for (int j = 0; j < 16; ++j) y[j] = 0.f;
#define P10_ACC(gt_, w0_, w1_) do { y[0] += gt_ * bflo(w0_.x); y[1] += gt_ * bfhi(w0_.x); y[2] += gt_ * bflo(w0_.y); y[3] += gt_ * bfhi(w0_.y); y[4] += gt_ * bflo(w0_.z); y[5] += gt_ * bfhi(w0_.z); y[6] += gt_ * bflo(w0_.w); y[7] += gt_ * bfhi(w0_.w); \
            y[8] += gt_ * bflo(w1_.x); y[9] += gt_ * bfhi(w1_.x); y[10] += gt_ * bflo(w1_.y); y[11] += gt_ * bfhi(w1_.y); y[12] += gt_ * bflo(w1_.z); y[13] += gt_ * bfhi(w1_.z); y[14] += gt_ * bflo(w1_.w); y[15] += gt_ * bfhi(w1_.w); } while (0)
        unsigned long long em = __ballot(sv >= 0);
        const int cnt = __popcll(em);
        float gtk[4]; u32x4 w0k[4], w1k[4];
#pragma unroll
        for (int k = 0; k < 4; ++k) if (cnt > k) { const int e = __builtin_ctzll(em); em &= em - 1; const int s_ = __builtin_amdgcn_readlane(sv, e);
            const size_t ri = (size_t)(b * NE + e) * CAP + s_; const bf16_t* row = mout + ri * DM;
            gtk[k] = __hip_atomic_load(gate + ri, __ATOMIC_RELAXED, __HIP_MEMORY_SCOPE_AGENT);
            w0k[k] = *(const u32x4*)(row + 8 * lane); w1k[k] = *(const u32x4*)(row + 512 + 8 * lane); }
#pragma unroll
        for (int k = 0; k < 4; ++k) if (cnt > k) P10_ACC(gtk[k], w0k[k], w1k[k]);
        while (em) { const int e = __builtin_ctzll(em); em &= em - 1; const int s_ = __builtin_amdgcn_readlane(sv, e);
            const size_t ri = (size_t)(b * NE + e) * CAP + s_; const bf16_t* row = mout + ri * DM;
            const float gt = __hip_atomic_load(gate + ri, __ATOMIC_RELAXED, __HIP_MEMORY_SCOPE_AGENT);
            const u32x4 w0 = *(const u32x4*)(row + 8 * lane), w1 = *(const u32x4*)(row + 512 + 8 * lane);
            P10_ACC(gt, w0, w1); }
#undef P10_ACC
        float xf[16]; float ss = 0.f;
#pragma unroll
        for (int hlf = 0; hlf < 2; ++hlf) { const u32x4 mw = mw2[hlf];
            const float mv[8] = {bflo(mw.x), bfhi(mw.x), bflo(mw.y), bfhi(mw.y), bflo(mw.z), bfhi(mw.z), bflo(mw.w), bfhi(mw.w)};
#pragma unroll
            for (int q = 0; q < 2; ++q) { const int col = hlf * 512 + 8 * lane + 4 * q; const f32x4 g2 = *(const f32x4*)(md + col);
#pragma unroll
                for (int j = 0; j < 4; ++j) { const float t = mv[q * 4 + j] + g2[j] * y[hlf * 8 + q * 4 + j]; xf[hlf * 8 + q * 4 + j] = t; ss += t * t; } } }
        const float rstd = rsqrtf(wave_sum(ss) * (1.0f / DM) + EPS);
#pragma unroll
        for (int hlf = 0; hlf < 2; ++hlf)
#pragma unroll
            for (int q = 0; q < 2; ++q) { const int col = hlf * 512 + 8 * lane + 4 * q; const f32x4 fg = *(const f32x4*)(A.final_g + col); f32x4 o;
#pragma unroll
                for (int j = 0; j < 4; ++j) o[j] = xf[hlf * 8 + q * 4 + j] * rstd * fg[j];
                *(f32x4*)(xr + col) = o; }
    }
}

constexpr int CW_CTX = 96;
DI void block_handoff(Frame& F) { asm volatile("s_waitcnt vmcnt(0)" ::: "memory"); __syncthreads(); if (F.tid == 0) { __builtin_amdgcn_fence(__ATOMIC_ACQUIRE, "agent"); asm volatile("s_waitcnt vmcnt(0)" ::: "memory"); } __syncthreads(); frame_refresh(F); }
constexpr int CW_WFLAG = 64;
__global__ void __launch_bounds__(NTHR, 2) hymba_fwd(Args args) {
    extern __shared__ __attribute__((aligned(16))) unsigned char lds_raw[];
    Frame F;
    F.lds = (LAS unsigned char*)lds_raw; F.wave = __builtin_amdgcn_readfirstlane((int)threadIdx.x >> 6); frame_refresh(F);
    const int gblk = blockIdx.x, gn = gridDim.x;
    const int nl = (gn % 16 == 0) ? N_LANES : 1;
    const int lid = nl == 2 ? ((gblk >> 3) & 1) : 0, lblk = nl == 2 ? ((gblk & 7) | ((gblk >> 4) << 3)) : gblk, lnblk = gn / nl;
    volatile LAS unsigned* MISC = (volatile LAS unsigned*)(F.lds + MISC_OFF);
    if (F.tid < 32) MISC[F.tid] = 0u;
    __syncthreads();
    unsigned* const ctl = (unsigned*)(args.ws + WS_CTL);
    XcdBarrier gbar = xcd_barrier_post(ctl + 4096, MISC + 8, F.tid == 0, (unsigned)gn);
    XcdBarrier lbar = xcd_barrier_post(ctl + 4096 + (1 + lid) * XCD_BAR_WORDS, MISC + 10, F.tid == 0, (unsigned)lnblk);
#define LBAR() do { frame_refresh(F); xcd_barrier(lbar, F.tid == 0); frame_refresh(F); } while (0)

    F.blk = gblk; F.nblk = gn; F.b0 = 0; F.nb = NB;
    p0_prologue(F); __syncthreads(); p0_transposes<0>(F);
    frame_refresh(F); xcd_barrier(gbar, F.tid == 0); frame_refresh(F);

    F.blk = lblk; F.nblk = lnblk; F.nb = NB / nl; F.b0 = lid * F.nb;
    if (lid == nl - 1) {
        p0_transposes<1>(F);
        LBAR();
        if (lblk == 0 && F.tid == 0) __hip_atomic_store(ctl + CW_WFLAG, 1u, __ATOMIC_RELAXED, __HIP_MEMORY_SCOPE_AGENT);
    }
    p1_rows(F, MTOK + F.b0 * CTXL, F.nb * CTXL, F.blk * NWAVES + F.wave, F.nblk * NWAVES);
    block_handoff(F);
    if (F.tid == 0) { __builtin_amdgcn_fence(__ATOMIC_RELEASE, "agent"); asm volatile("s_waitcnt vmcnt(0)" ::: "memory"); (void)xb_add(ctl + CW_CTX + lid, 1u); }
    for (int tile = F.b0 * 16 + F.blk; tile < (F.b0 + F.nb) * 16; tile += F.nblk) p1_rows(F, tile * 256, 256, F.wave, NWAVES);
    block_handoff(F);
    { KArgs* Ap = kargs_fresh(); ProbDense P; P.A = WSP(bf16_t, Ap, WS_H); P.Bt = WSP(bf16_t, Ap, WS_WIN); P.K = DM; P.ord.init_own(F.nb * 16, INC / 256, F.nblk, F.blk, F.b0 * 16);
      EpiPlanes E{WSP(bf16_t, Ap, WS_PL)}; pg8::gemm_phase<ProbDense, EpiPlanes, true>(F.lds, F.tid, P, E); }
    frame_refresh(F);
    {
        if (F.tid == 0) { unsigned sp = 0; while (xb_ld(ctl + CW_CTX + lid) < (unsigned)F.nblk) { __builtin_amdgcn_s_sleep(8); if (++sp > (1u << 22)) break; }
            __builtin_amdgcn_fence(__ATOMIC_ACQUIRE, "agent"); asm volatile("s_waitcnt vmcnt(0)" ::: "memory"); }
        __syncthreads();
        KArgs* Ap = kargs_fresh(); ProbDense P; P.A = WSP(bf16_t, Ap, WS_H) + (size_t)MTOK * DM; P.Bt = WSP(bf16_t, Ap, WS_WIN) + (size_t)OFF_I * DM; P.K = DM; P.ord.init(F.nb, PCW / 256, F.nblk, F.blk, F.b0);
        EpiCtxPlanes E{WSP(bf16_t, Ap, WS_PCTX)}; pg8::gemm_phase<ProbDense, EpiCtxPlanes, true>(F.lds, F.tid, P, E);
    }
    LBAR();
    {
        const int gwv = F.blk * NWAVES + F.wave, ngw = F.nblk * NWAVES, nconv = F.nb * 64 * 2 * 2, nprep = F.nb * 64 * NH + F.nb * 4 * NH;
        const bool prep_first = F.wave >= 4;
        if (prep_first) for (int it = gwv; it < nprep; it += ngw) prep_item(F, it);
        for (int it = gwv; it < nconv; it += ngw) conv_item(F, it);
        if (!prep_first) for (int it = gwv; it < nprep; it += ngw) prep_item(F, it);
    }
    LBAR();
    {
        const int nscan = F.nb * NH * 2 * 2;
        for (int it = F.blk; it < nscan; it += F.nblk) { const int x = it & 7, y = it >> 3; scan_item(F, ((x + 8 * (y >> 1)) << 1) | (y & 1)); }
    }
    LBAR();
    for (int tile = F.b0 * 16 + F.blk; tile < (F.b0 + F.nb) * 16; tile += F.nblk) p4_mixed(F, tile * 256, tile * 256 + 256, F.wave, NWAVES);
    block_handoff(F);
    { KArgs* Ap = kargs_fresh(); ProbDense P; P.A = WSP(bf16_t, Ap, WS_H); P.Bt = WSP(bf16_t, Ap, WS_WOUT); P.K = DM; P.ord.init_own(F.nb * 16, DM / 256, F.nblk, F.blk, F.b0 * 16);
      EpiX1 E{WSP(bf16_t, Ap, WS_MIX), Ap->x, WSP(float, Ap, WS_MOD)}; pg8::gemm_phase<ProbDense, EpiX1, true>(F.lds, F.tid, P, E); }
    block_handoff(F);
    p6_rows(F);
    LBAR();
    {
        if (F.tid == 0) { unsigned sp = 0; while (__hip_atomic_load(ctl + CW_WFLAG, __ATOMIC_RELAXED, __HIP_MEMORY_SCOPE_AGENT) == 0u) { __builtin_amdgcn_s_sleep(8); if (++sp > (1u << 22)) break; }
            __builtin_amdgcn_fence(__ATOMIC_ACQUIRE, "agent"); asm volatile("s_waitcnt vmcnt(0)" ::: "memory"); }
        __syncthreads();
    }
    for (int gl = F.blk; gl < F.nb * NE; gl += F.nblk) {
        const int e = 2 * (gl & 7) + ((gl >> 3) & 1), b = F.b0 + (gl >> 4), g = b * NE + e, gm = e * 32 + b * 2;
        topk_item(F, g);
        block_handoff(F);
        { KArgs* Ap = kargs_fresh(); ProbMoeUp P; P.A = WSP(unsigned char, Ap, WS_H2); P.Bt = WSP(unsigned char, Ap, WS_WGU); P.idx = WSP(int, Ap, WS_IDX); P.K = DM; P.ord.init_group(2 * FF / 256, gm);
          EpiSwiglu E{WSP(unsigned char, Ap, WS_HID)}; pg8::gemm_phase<ProbMoeUp, EpiSwiglu, true>(F.lds, F.tid, P, E); }
        block_handoff(F);
        { KArgs* Ap = kargs_fresh(); ProbMoeDown P; P.A = WSP(unsigned char, Ap, WS_HID); P.Bt = WSP(unsigned char, Ap, WS_WDN); P.K = FF; P.ord.init_group(DM / 256, gm);
          EpiDown E{WSP(bf16_t, Ap, WS_MOUT)}; pg8::gemm_phase<ProbMoeDown, EpiDown, true>(F.lds, F.tid, P, E); }
        frame_refresh(F);
    }
    LBAR();
    p10_final(F);
#undef LBAR
}

extern "C" void kernel_launch(void* const* d_in, const int* in_sizes, int n_in, void* d_out, int out_size, void* d_ws, size_t ws_size, hipStream_t stream) {
    static int grid = 0;
    if (grid == 0) {
        if (n_in != 21 || in_sizes[0] != MTOK * DM || out_size != MTOK * DM || ws_size < WS_END) { fprintf(stderr, "kernel_launch: unexpected shapes (n_in %d, in0 %d, out %d, ws %zu)\n", n_in, n_in > 0 ? in_sizes[0] : -1, out_size, ws_size); grid = -1; return; }
        int dev = 0, cus = 0, per_cu = 0;
        if (hipGetDevice(&dev) != hipSuccess || hipDeviceGetAttribute(&cus, hipDeviceAttributeMultiprocessorCount, dev) != hipSuccess) { grid = -1; return; }
        if (hipFuncSetAttribute((const void*)hymba_fwd, hipFuncAttributeMaxDynamicSharedMemorySize, LDS_BYTES) != hipSuccess) { fprintf(stderr, "kernel_launch: hipFuncSetAttribute failed\n"); grid = -1; return; }
        if (hipOccupancyMaxActiveBlocksPerMultiprocessor(&per_cu, (const void*)hymba_fwd, NTHR, LDS_BYTES) != hipSuccess || per_cu < 1) { fprintf(stderr, "kernel_launch: occupancy query says %d\n", per_cu); per_cu = 1; }
        (void)hipGetLastError();
        grid = cus * (per_cu < 1 ? 1 : 1);
    }
    if (grid < 0) return;
    Args a{};
    const float** ap = (const float**)&a;
    for (int i = 0; i < 21; ++i) ap[i] = (const float*)d_in[i];
    a.out = (float*)d_out; a.ws = (unsigned char*)d_ws;
#if BARRIER_KIND == 1
    if (hipMemsetAsync((char*)d_ws + WS_CTL, 0, 65536, stream) != hipSuccess) { fprintf(stderr, "kernel_launch: memset failed\n"); return; }
#endif
    void* kargs[] = {&a};
    const hipError_t le = hipLaunchCooperativeKernel((const void*)hymba_fwd, dim3(grid), dim3(NTHR), kargs, LDS_BYTES, stream);
    if (le != hipSuccess) fprintf(stderr, "kernel_launch: cooperative launch failed: %s (grid %d)\n", hipGetErrorString(le), grid);
}
```
